# Optimizing an MI355X kernel written in HIP

```python
import math
import jax, jax.numpy as jnp
from jax import lax
import numpy as np

D_MODEL = 1024
BATCH = 4
SEQ = 8192
DEPTH = 1

N_DIFF_HEADS = 4
DIFF_QK_DIM = 64
DIFF_V_DIM = 2 * DIFF_QK_DIM
DIFF_WIDTH = N_DIFF_HEADS * DIFF_V_DIM
N_RET_HEADS = 4
RET_QK_DIM = 64
RET_V_DIM = 2 * RET_QK_DIM
RET_WIDTH = N_RET_HEADS * RET_V_DIM
MIX_WIDTH = DIFF_WIDTH + RET_WIDTH
PROJ_SIZES = (
    N_DIFF_HEADS * 2 * DIFF_QK_DIM,
    N_DIFF_HEADS * 2 * DIFF_QK_DIM,
    DIFF_WIDTH,
    N_RET_HEADS * RET_QK_DIM,
    N_RET_HEADS * RET_QK_DIM,
    RET_WIDTH,
    RET_WIDTH,
)
PROJ_WIDTH = sum(PROJ_SIZES)
PROJ_SPLITS = tuple(int(s) for s in np.cumsum(PROJ_SIZES)[:-1])

ROPE_THETA = 10000.0
Q_BLOCK = 128
RET_CHUNK = 128
RMS_EPS = 1e-5

N_EXPERTS = 32
TOP_K = 4
D_FF_EXPERT = D_MODEL
SWIGLU_LIMIT = 7.0
SWIGLU_ALPHA = 1.702
MOE_BLOCK = 128

kernel_name = 'hybrid_diffattn_retention_moe'


def rms_norm(x, g):
    xf = x.astype(jnp.float32)
    y = xf * lax.rsqrt(jnp.mean(xf * xf, axis=-1, keepdims=True) + RMS_EPS)
    return (y * g.astype(jnp.float32)).astype(x.dtype)


def rope(x, positions):
    d = x.shape[-1]
    inv_freq = 1.0 / (ROPE_THETA ** (jnp.arange(0, d, 2, dtype=jnp.float32) / d))
    ang = positions.astype(jnp.float32)[..., None] * inv_freq
    ang = ang.reshape(ang.shape[:2] + (1,) * (x.ndim - 3) + (d // 2,))
    cos = jnp.concatenate([jnp.cos(ang), jnp.cos(ang)], axis=-1)
    sin = jnp.concatenate([jnp.sin(ang), jnp.sin(ang)], axis=-1)
    xf = x.astype(jnp.float32)
    x1, x2 = xf[..., : d // 2], xf[..., d // 2:]
    rot = jnp.concatenate([-x2, x1], axis=-1)
    return (xf * cos + rot * sin).astype(x.dtype)


def diff_attention(q, k, v, lam):
    B, S, H, _ = v.shape
    n_blocks = S // Q_BLOCK
    scale = DIFF_QK_DIM ** -0.5
    k_pos = jnp.arange(S)

    def block(i):
        start = i * Q_BLOCK
        qb = lax.dynamic_slice_in_dim(q, start, Q_BLOCK, axis=1)
        s = jnp.einsum('bqhmd,bkhmd->bhmqk', qb, k,
                       preferred_element_type=jnp.float32) * scale
        q_pos = start + jnp.arange(Q_BLOCK)
        causal = k_pos[None, :] <= q_pos[:, None]
        s = jnp.where(causal, s, -jnp.inf)
        p = jax.nn.softmax(s, axis=-1)
        a = p[:, :, 0] - lam * p[:, :, 1]
        return jnp.einsum('bhqk,bkhd->bqhd', a.astype(v.dtype), v)

    out = lax.map(block, jnp.arange(n_blocks))
    return jnp.moveaxis(out, 0, 1).reshape(B, S, H, v.shape[-1])


def retention(q, k, v, log_decay):
    B, S, H, dk = q.shape
    dv = v.shape[-1]
    C = RET_CHUNK
    nc = S // C
    q = q.reshape(B, nc, C, H, dk)
    k = (k * (dk ** -0.5)).reshape(B, nc, C, H, dk)
    v = v.reshape(B, nc, C, H, dv)
    idx = jnp.arange(C, dtype=jnp.float32)
    rel = idx[:, None] - idx[None, :]
    intra_decay = jnp.where(rel >= 0,
                            jnp.exp(log_decay[:, None, None] * jnp.maximum(rel, 0.0)),
                            0.0)
    scores = jnp.einsum('bnihd,bnjhd->bnhij', q, k,
                        preferred_element_type=jnp.float32) * intra_decay
    y_intra = jnp.einsum('bnhij,bnjhe->bnihe', scores, v.astype(jnp.float32))
    k_decay = jnp.exp(log_decay[None, :] * (C - 1 - idx)[:, None])
    kv = jnp.einsum('bnjhd,jh,bnjhe->bnhde', k.astype(jnp.float32), k_decay,
                    v.astype(jnp.float32))
    chunk_decay = jnp.exp(log_decay * C)[None, :, None, None]

    def step(state, kv_c):
        return chunk_decay * state + kv_c, state

    init = jnp.zeros((B, H, dk, dv), jnp.float32)
    _, prev = lax.scan(step, init, jnp.moveaxis(kv, 1, 0))
    prev = jnp.moveaxis(prev, 0, 1)
    q_decay = jnp.exp(log_decay[None, :] * (idx + 1.0)[:, None])
    y_cross = jnp.einsum('bnihd,ih,bnhde->bnihe', q.astype(jnp.float32), q_decay, prev)
    return (y_intra + y_cross).reshape(B, S, H, dv).astype(v.dtype)


def moe(x2d, w_router, b_router, w_in, b_in, w_out, b_out):
    N, D = x2d.shape
    logits = (x2d @ w_router).astype(jnp.float32) + b_router.astype(jnp.float32)
    top_val, top_idx = lax.top_k(logits, TOP_K)
    gates = jax.nn.softmax(top_val, axis=-1)
    NK = N * TOP_K
    e_flat = top_idx.reshape(NK)
    tok = jnp.arange(NK) // TOP_K
    order = jnp.argsort(e_flat)
    e_s = e_flat[order]
    tok_s = tok[order]
    g_s = gates.reshape(NK)[order]
    counts = jnp.bincount(e_flat, length=N_EXPERTS)
    offsets = jnp.cumsum(counts) - counts
    padded = ((counts + MOE_BLOCK - 1) // MOE_BLOCK) * MOE_BLOCK
    pad_end = jnp.cumsum(padded)
    pad_off = pad_end - padded
    dest = pad_off[e_s] + (jnp.arange(NK) - offsets[e_s])
    P = ((NK + MOE_BLOCK - 1) // MOE_BLOCK) * MOE_BLOCK + N_EXPERTS * MOE_BLOCK
    n_blk = P // MOE_BLOCK
    x_buf = jnp.zeros((P, D), x2d.dtype).at[dest].set(x2d[tok_s])
    blk_expert = jnp.minimum(
        jnp.searchsorted(pad_end, jnp.arange(n_blk) * MOE_BLOCK, side='right'),
        N_EXPERTS - 1)

    def expert_block(args):
        xb, e = args
        h = xb @ w_in[e] + b_in[e]
        glu = jnp.minimum(h[:, ::2], SWIGLU_LIMIT)
        lin = jnp.clip(h[:, 1::2], -SWIGLU_LIMIT, SWIGLU_LIMIT)
        act = glu * jax.nn.sigmoid(SWIGLU_ALPHA * glu) * (lin + 1.0)
        return act @ w_out[e] + b_out[e]

    y_buf = lax.map(expert_block,
                    (x_buf.reshape(n_blk, MOE_BLOCK, D), blk_expert)).reshape(P, D)
    y = y_buf[dest] * g_s[:, None].astype(y_buf.dtype)
    return jax.ops.segment_sum(y, tok_s, num_segments=N)


def setup_inputs(seed: int = 0) -> dict:
    key = jax.random.key(seed)
    ks = jax.random.split(key, 20)
    f32 = jnp.float32
    L = DEPTH
    x = jax.random.normal(ks[0], (BATCH, SEQ, D_MODEL), f32)
    positions = jnp.broadcast_to(jnp.arange(SEQ, dtype=jnp.int32), (BATCH, SEQ))
    norm1_g = 1.0 + 0.02 * jax.random.normal(ks[1], (L, D_MODEL), f32)
    w_in = jax.random.normal(ks[2], (L, D_MODEL, PROJ_WIDTH), f32) * D_MODEL ** -0.5
    lambda_q1 = 0.1 * jax.random.normal(ks[3], (L, DIFF_QK_DIM), f32)
    lambda_k1 = 0.1 * jax.random.normal(ks[4], (L, DIFF_QK_DIM), f32)
    lambda_q2 = 0.1 * jax.random.normal(ks[5], (L, DIFF_QK_DIM), f32)
    lambda_k2 = 0.1 * jax.random.normal(ks[6], (L, DIFF_QK_DIM), f32)
    diff_norm_g = 1.0 + 0.02 * jax.random.normal(ks[7], (L, DIFF_V_DIM), f32)
    ret_norm_g = 1.0 + 0.02 * jax.random.normal(ks[8], (L, N_RET_HEADS, RET_V_DIM), f32)
    w_o = jax.random.normal(ks[9], (L, MIX_WIDTH, D_MODEL), f32) * MIX_WIDTH ** -0.5
    norm2_g = 1.0 + 0.02 * jax.random.normal(ks[10], (L, D_MODEL), f32)
    w_router = jax.random.normal(ks[11], (L, D_MODEL, N_EXPERTS), f32) * D_MODEL ** -0.5
    b_router = 0.01 * jax.random.normal(ks[12], (L, N_EXPERTS), f32)
    w_moe_in = jax.random.normal(ks[13], (L, N_EXPERTS, D_MODEL, 2 * D_FF_EXPERT), f32) * D_MODEL ** -0.5
    b_moe_in = 0.01 * jax.random.normal(ks[14], (L, N_EXPERTS, 2 * D_FF_EXPERT), f32)
    w_moe_out = jax.random.normal(ks[15], (L, N_EXPERTS, D_FF_EXPERT, D_MODEL), f32) * D_FF_EXPERT ** -0.5
    b_moe_out = 0.01 * jax.random.normal(ks[16], (L, N_EXPERTS, D_MODEL), f32)
    norm_f_g = 1.0 + 0.02 * jax.random.normal(ks[17], (D_MODEL,), f32)
    return {'x': x, 'positions': positions, 'norm1_g': norm1_g, 'w_in': w_in,
            'lambda_q1': lambda_q1, 'lambda_k1': lambda_k1,
            'lambda_q2': lambda_q2, 'lambda_k2': lambda_k2,
            'diff_norm_g': diff_norm_g, 'ret_norm_g': ret_norm_g, 'w_o': w_o,
            'norm2_g': norm2_g, 'w_router': w_router, 'b_router': b_router,
            'w_moe_in': w_moe_in, 'b_moe_in': b_moe_in,
            'w_moe_out': w_moe_out, 'b_moe_out': b_moe_out, 'norm_f_g': norm_f_g}


def reference(x, positions, norm1_g, w_in, lambda_q1, lambda_k1, lambda_q2, lambda_k2,
              diff_norm_g, ret_norm_g, w_o, norm2_g, w_router, b_router,
              w_moe_in, b_moe_in, w_moe_out, b_moe_out, norm_f_g):
    B, S, D = x.shape
    log_decay = jnp.log(1.0 - 2.0 ** (-5.0 - jnp.arange(N_RET_HEADS, dtype=jnp.float32)))
    for l in range(DEPTH):
        h = rms_norm(x, norm1_g[l])
        proj = h @ w_in[l]
        dq, dk, dv, rq, rk, rv, rg = jnp.split(proj, PROJ_SPLITS, axis=-1)
        dq = rope(dq.reshape(B, S, N_DIFF_HEADS, 2, DIFF_QK_DIM), positions)
        dk = rope(dk.reshape(B, S, N_DIFF_HEADS, 2, DIFF_QK_DIM), positions)
        dv = dv.reshape(B, S, N_DIFF_HEADS, DIFF_V_DIM)
        lam_init = 0.8 - 0.6 * math.exp(-0.3 * l)
        lam = (jnp.exp(jnp.sum(lambda_q1[l].astype(jnp.float32) * lambda_k1[l].astype(jnp.float32)))
               - jnp.exp(jnp.sum(lambda_q2[l].astype(jnp.float32) * lambda_k2[l].astype(jnp.float32)))
               + lam_init)
        d_out = diff_attention(dq, dk, dv, lam)
        d_out = rms_norm(d_out, diff_norm_g[l]) * (1.0 - lam_init)
        rq = rope(rq.reshape(B, S, N_RET_HEADS, RET_QK_DIM), positions)
        rk = rope(rk.reshape(B, S, N_RET_HEADS, RET_QK_DIM), positions)
        rv = rv.reshape(B, S, N_RET_HEADS, RET_V_DIM)
        r_out = rms_norm(retention(rq, rk, rv, log_decay), ret_norm_g[l])
        r_out = r_out.reshape(B, S, RET_WIDTH) * jax.nn.silu(rg)
        mix = jnp.concatenate([d_out.reshape(B, S, DIFF_WIDTH), r_out], axis=-1)
        x = x + mix @ w_o[l]
        h2 = rms_norm(x, norm2_g[l]).reshape(B * S, D)
        y = moe(h2, w_router[l], b_router[l], w_moe_in[l], b_moe_in[l],
                w_moe_out[l], b_moe_out[l])
        x = x + y.reshape(B, S, D)
    return rms_norm(x, norm_f_g)
```

```cpp
#include <hip/hip_runtime.h>
#include <hip/hip_cooperative_groups.h>
#include <cstdio>
#include <cstdint>
namespace cg = cooperative_groups;

#define LAS __attribute__((address_space(3)))
typedef unsigned short bf16_t;
typedef short bf16x8 __attribute__((ext_vector_type(8)));
typedef short s16x4 __attribute__((ext_vector_type(4)));
typedef float f32x4 __attribute__((ext_vector_type(4)));
typedef float f32x2 __attribute__((ext_vector_type(2)));
typedef float f32x16 __attribute__((ext_vector_type(16)));
typedef unsigned u32x4 __attribute__((ext_vector_type(4)));
typedef unsigned u32x2 __attribute__((ext_vector_type(2)));

constexpr int NB = 4, SEQ = 8192, DM = 1024, NTOK = NB * SEQ;
constexpr int PW = 3072;
constexpr int C_DQ = 0, C_DK = 512, C_DV = 1024, C_RQ = 1536, C_RK = 1792, C_RV = 2048, C_RG = 2560;
constexpr int NEXP = 32, TOPK = 4, FF = 1024;
constexpr int NCH = SEQ / 128;
constexpr int MAXTILES = (NTOK * TOPK) / 256 + NEXP;
constexpr float RMS_EPS = 1e-5f;
constexpr float LOG2E = 1.4426950408889634f;
constexpr float QSCALE = 0.125f * LOG2E;

constexpr size_t MiB = 1u << 20;
constexpr size_t WS_CTL = 0, CTL_ZERO_BYTES = 4096;
constexpr size_t WS_WIN = 2 * MiB;
constexpr size_t WS_WO = 8 * MiB;
constexpr size_t WS_WMI = 10 * MiB;
constexpr size_t WS_WMO = 138 * MiB;
constexpr size_t WS_ROPE = 202 * MiB;
constexpr size_t WS_TOPK = 210 * MiB;
constexpr size_t WS_A = 212 * MiB;
constexpr size_t WS_XN = WS_A, WS_PROJ = WS_A + 64 * MiB, WS_XG = WS_A, WS_Y = WS_A;
constexpr size_t WS_B = 484 * MiB;
constexpr size_t WS_MIX = WS_B, WS_KVT = WS_B + 64 * MiB, WS_PREVT = WS_B + 96 * MiB, WS_ACT = WS_B;
constexpr size_t WS_END = 756 * MiB;
constexpr int CW_CNT = 0;

constexpr int LDS_BYTES = 155648;
constexpr int LDS_MISC = 131072;
constexpr int NTHR = 512, NWAVES = 8;

__device__ __forceinline__ unsigned f2bf(float f) { unsigned u = __builtin_bit_cast(unsigned, f); return (u + 0x7fffu + ((u >> 16) & 1u)) >> 16; }
__device__ __forceinline__ unsigned pk2(float lo, float hi) { return f2bf(lo) | (f2bf(hi) << 16); }
__device__ __forceinline__ float bf2f(unsigned short b) { return __builtin_bit_cast(float, (unsigned)b << 16); }
__device__ __forceinline__ float bflo(unsigned w) { return __builtin_bit_cast(float, w << 16); }
__device__ __forceinline__ float bfhi(unsigned w) { return __builtin_bit_cast(float, w & 0xffff0000u); }
__device__ __forceinline__ float wave_sum(float v) {
#pragma unroll
    for (int o = 1; o < 64; o <<= 1) v += __shfl_xor(v, o);
    return v;
}
__device__ __forceinline__ int crow(int r, int hi) { return (r & 3) + 8 * (r >> 2) + 4 * hi; }
__device__ __forceinline__ s16x4 tr_read(const LAS unsigned char* p) {
    typedef short v4i16_t __attribute__((ext_vector_type(4)));
    return __builtin_bit_cast(s16x4, __builtin_amdgcn_ds_read_tr16_b64_v4i16((LAS v4i16_t*)p));
}
__device__ __forceinline__ bf16x8 cat8(s16x4 lo, s16x4 hi) { return (bf16x8){lo[0], lo[1], lo[2], lo[3], hi[0], hi[1], hi[2], hi[3]}; }
__device__ __forceinline__ bf16x8 pack8(const f32x16& p, int b) {
    u32x4 w; w.x = pk2(p[b], p[b + 1]); w.y = pk2(p[b + 2], p[b + 3]); w.z = pk2(p[b + 4], p[b + 5]); w.w = pk2(p[b + 6], p[b + 7]);
    return __builtin_bit_cast(bf16x8, w);
}
#define MFMA32(a, b, c) __builtin_amdgcn_mfma_f32_32x32x16_bf16((a), (b), (c), 0, 0, 0)

namespace pg8 {
constexpr int BM = 256, BK = 64, HALF = 128, HTB = HALF * BK * 2, STAGE_BYTES = 8 * HTB, NXCD = 8;
__host__ __device__ __forceinline__ int lds_byte(int r, int c) { const int st = (r >> 4) * 2 + (c >> 5), rr = r & 15, cc = c & 31, ob = rr * 64 + cc * 2; return st * 1024 + (ob ^ (((ob >> 9) & 1) << 5)); }
__host__ __device__ __forceinline__ void stage_rc(int b, int& R, int& C) { const int st = b / 1024, sb = b % 1024, swz = sb ^ (((sb >> 9) & 1) << 5); R = (st >> 1) * 16 + swz / 64; C = (st & 1) * 32 + (swz % 64) / 2; }
__host__ __device__ __forceinline__ int perm32(int rho) { const int n = rho >> 4, i = rho & 15; return 8 * (i >> 2) + 4 * n + (i & 3); }

struct Unit { int pm, pn, e; };
struct Gemm { const bf16_t* A; const bf16_t* Bt; int K; size_t estride; };

struct StaticOrder {
    int nM, nN, nwg, G, c;
    __device__ void init(int M, int N, int G_, int c_) { nM = M / BM; nN = N / BM; nwg = nM * nN; G = G_; c = c_; }
    __device__ bool next(int i, Unit& u) const {
        const long L = (long)i * G + c; if (L >= nwg) return false;
        int wgid = (int)L; { const int q = nwg / NXCD, r = nwg % NXCD, xcd = wgid % NXCD, off = wgid / NXCD; wgid = (xcd < r ? xcd * (q + 1) : r * (q + 1) + (xcd - r) * q) + off; }
        const int nig = 8 * nN, gid = wgid / nig, fm = gid * 8, gsz = (nM - fm) < 8 ? (nM - fm) : 8;
        u.pm = fm + ((wgid % nig) % gsz); u.pn = (wgid % nig) / gsz; u.e = 0; return true;
    }
};
struct GroupedOrder {
    int ntiles, nN, nwg, G, c; const LAS unsigned char* tile_e;
    __device__ bool next(int i, Unit& u) const {
        const long L = (long)i * G + c; if (L >= nwg) return false;
        int wgid = (int)L; { const int q = nwg / NXCD, r = nwg % NXCD, xcd = wgid % NXCD, off = wgid / NXCD; wgid = (xcd < r ? xcd * (q + 1) : r * (q + 1) + (xcd - r) * q) + off; }
        u.pm = wgid / nN; u.pn = wgid % nN; u.e = tile_e[u.pm]; return true;
    }
};

__device__ __forceinline__ unsigned cvt_pk_bf16(float lo, float hi) { unsigned r; asm volatile("v_cvt_pk_bf16_f32 %0, %1, %2" : "=v"(r) : "v"(lo), "v"(hi)); return r; }

struct EpiProj {
    static constexpr bool PERM = true;
    bf16_t* O; const float* rope;
    __device__ __forceinline__ void operator()(const f32x4 (&acc)[2][2][4][2], const Unit& u, int wr, int wc, int fr, int fq) const {
        const int pn = u.pn;
        const bool isrope = (pn < 4) || pn == 6 || pn == 7;
        const float sc = (pn < 2) ? QSCALE : (pn == 7 ? 0.125f : 1.0f);
        const int row0 = u.pm * BM + wr * 64 + fr, col0 = pn * BM + wc * 32 + 8 * fq, ri = 16 * (wc & 1) + 4 * fq;
#pragma unroll
        for (int ai = 0; ai < 2; ++ai)
#pragma unroll
            for (int m = 0; m < 4; ++m) {
                const int row = row0 + ai * HALF + m * 16;
                bf16_t* rowp = O + (size_t)row * PW + col0;
                f32x4 cs = (f32x4){1.f, 1.f, 1.f, 1.f}, sn = (f32x4){0.f, 0.f, 0.f, 0.f};
                if (isrope) { cs = *(const f32x4*)(rope + (size_t)row * 64 + ri); sn = *(const f32x4*)(rope + (size_t)row * 64 + 32 + ri); }
#pragma unroll
                for (int bj = 0; bj < 2; ++bj) {
                    const f32x4 a0 = acc[ai][bj][m][0], a1 = acc[ai][bj][m][1];
                    f32x4 v0 = (a0 * cs - a1 * sn) * sc, v1 = (a1 * cs + a0 * sn) * sc;
                    u32x4 w; w.x = cvt_pk_bf16(v0[0], v0[1]); w.y = cvt_pk_bf16(v0[2], v0[3]); w.z = cvt_pk_bf16(v1[0], v1[1]); w.w = cvt_pk_bf16(v1[2], v1[3]);
                    *(u32x4*)(rowp + bj * HALF) = w;
                }
            }
    }
};
struct EpiRes {
    static constexpr bool PERM = true;
    const float* X; float* O;
    __device__ __forceinline__ void operator()(const f32x4 (&acc)[2][2][4][2], const Unit& u, int wr, int wc, int fr, int fq) const {
        const int row0 = u.pm * BM + wr * 64 + fr, col0 = u.pn * BM + wc * 32 + 8 * fq;
#pragma unroll
        for (int ai = 0; ai < 2; ++ai)
#pragma unroll
            for (int m = 0; m < 4; ++m) {
                const size_t off = (size_t)(row0 + ai * HALF + m * 16) * DM + col0;
#pragma unroll
                for (int bj = 0; bj < 2; ++bj)
#pragma unroll
                    for (int n = 0; n < 2; ++n) { const f32x4 xv = *(const f32x4*)(X + off + bj * HALF + n * 4); *(f32x4*)(O + off + bj * HALF + n * 4) = xv + acc[ai][bj][m][n]; }
            }
    }
};
struct EpiSwiglu {
    static constexpr bool PERM = true;
    bf16_t* O; const float* bias;
    __device__ __forceinline__ void operator()(const f32x4 (&acc)[2][2][4][2], const Unit& u, int wr, int wc, int fr, int fq) const {
        const int row0 = u.pm * BM + wr * 64 + fr, a0 = u.pn * 128 + wc * 16 + 4 * fq;
        f32x4 bg[2], bl[2];
#pragma unroll
        for (int bj = 0; bj < 2; ++bj) {
            const float* bp = bias + (size_t)u.e * 2048 + 2 * (a0 + 64 * bj);
            const f32x4 t0 = *(const f32x4*)bp, t1 = *(const f32x4*)(bp + 4);
            bg[bj] = (f32x4){t0[0], t0[2], t1[0], t1[2]}; bl[bj] = (f32x4){t0[1], t0[3], t1[1], t1[3]};
        }
#pragma unroll
        for (int ai = 0; ai < 2; ++ai)
#pragma unroll
            for (int m = 0; m < 4; ++m) {
                bf16_t* rowp = O + (size_t)(row0 + ai * HALF + m * 16) * FF + a0;
#pragma unroll
                for (int bj = 0; bj < 2; ++bj) {
                    const f32x4 g = acc[ai][bj][m][0] + bg[bj], l = acc[ai][bj][m][1] + bl[bj];
                    float o[4];
#pragma unroll
                    for (int j = 0; j < 4; ++j) {
                        const float gl = fminf(g[j], 7.0f), li = fminf(fmaxf(l[j], -7.0f), 7.0f);
                        const float sg = __builtin_amdgcn_rcpf(1.0f + __builtin_amdgcn_exp2f(-1.702f * LOG2E * gl));
                        o[j] = gl * sg * (li + 1.0f);
                    }
                    u32x2 w; w.x = cvt_pk_bf16(o[0], o[1]); w.y = cvt_pk_bf16(o[2], o[3]);
                    *(u32x2*)(rowp + 64 * bj) = w;
                }
            }
    }
};
struct EpiY {
    static constexpr bool PERM = true;
    bf16_t* O; const float* bias;
    __device__ __forceinline__ void operator()(const f32x4 (&acc)[2][2][4][2], const Unit& u, int wr, int wc, int fr, int fq) const {
        const int row0 = u.pm * BM + wr * 64 + fr, col0 = u.pn * BM + wc * 32 + 8 * fq;
        f32x4 bv[2][2];
#pragma unroll
        for (int bj = 0; bj < 2; ++bj)
#pragma unroll
            for (int n = 0; n < 2; ++n) bv[bj][n] = *(const f32x4*)(bias + (size_t)u.e * DM + col0 + bj * HALF + 4 * n);
#pragma unroll
        for (int ai = 0; ai < 2; ++ai)
#pragma unroll
            for (int m = 0; m < 4; ++m) {
                bf16_t* rowp = O + (size_t)(row0 + ai * HALF + m * 16) * DM + col0;
#pragma unroll
                for (int bj = 0; bj < 2; ++bj) {
                    const f32x4 v0 = acc[ai][bj][m][0] + bv[bj][0], v1 = acc[ai][bj][m][1] + bv[bj][1];
                    u32x4 w; w.x = cvt_pk_bf16(v0[0], v0[1]); w.y = cvt_pk_bf16(v0[2], v0[3]); w.z = cvt_pk_bf16(v1[0], v1[1]); w.w = cvt_pk_bf16(v1[2], v1[3]);
                    *(u32x4*)(rowp + bj * HALF) = w;
                }
            }
    }
};

template <class Epi, class Sched>
__device__ __forceinline__ void gemm_phase(LAS unsigned char* lds, const Gemm g, const Sched& S, const Epi& E) {
    const int tid = threadIdx.x, wid = __builtin_amdgcn_readfirstlane(tid >> 6), lane = tid & 63, wr = wid >> 2, wc = wid & 3, fr = lane & 15, fq = lane >> 4;
    const int K = g.K, nt = K / BK;
    unsigned voffA[2], voffB[2];
#pragma unroll
    for (int i = 0; i < 2; ++i) { int R, C; stage_rc(tid * 16 + i * 8192, R, C); const int Rb = Epi::PERM ? ((R & ~31) + perm32(R & 31)) : R;
        voffA[i] = (unsigned)(R * K + C) * 2u; voffB[i] = (unsigned)(Rb * K + C) * 2u; }
    const size_t kstep = (size_t)(BK * 2);
    const size_t hstep = (size_t)HALF * K * 2;
    const size_t tstep = 2 * hstep;
    const unsigned ldsw = (unsigned)wid * 1024u;
    const int aoff = lds_byte(wr * 64 + fr, fq * 8), boff = lds_byte(wc * 32 + fr, fq * 8);
#define PG8_SA(b, h) (((b) * 2 + (h)) * HTB)
#define PG8_SB(b, h) ((4 + (b) * 2 + (h)) * HTB)
#define PG8_STAGE(bufoff, gbase, voff) do { _Pragma("unroll") for (int _i = 0; _i < 2; ++_i) \
        __builtin_amdgcn_global_load_lds((const unsigned*)((const char*)(gbase) + (voff)[_i]), (LAS unsigned*)(lds + (bufoff) + ldsw + _i * 8192), 16, 0, 0); } while (0)
#define PG8_LDA(dst, b, h) do { _Pragma("unroll") for (int m = 0; m < 4; ++m) _Pragma("unroll") for (int k = 0; k < 2; ++k) dst[m][k] = *(const LAS bf16x8*)(lds + PG8_SA(b, h) + aoff + m * 2048 + k * 1024); } while (0)
#define PG8_LDB(dst, b, h) do { _Pragma("unroll") for (int n = 0; n < 2; ++n) _Pragma("unroll") for (int k = 0; k < 2; ++k) dst[n][k] = *(const LAS bf16x8*)(lds + PG8_SB(b, h) + boff + n * 2048 + k * 1024); } while (0)
#define PG8_MMA(ai, bj, At, Bt) do { __builtin_amdgcn_s_setprio(1); _Pragma("unroll") for (int m = 0; m < 4; ++m) _Pragma("unroll") for (int n = 0; n < 2; ++n) _Pragma("unroll") for (int k = 0; k < 2; ++k) \
        acc[ai][bj][m][n] = __builtin_amdgcn_mfma_f32_16x16x32_bf16(Bt[n][k], At[m][k], acc[ai][bj][m][n], 0, 0, 0); __builtin_amdgcn_s_setprio(0); } while (0)
#define PG8_WAIT_V(n) asm volatile("s_waitcnt vmcnt(" #n ")" ::: "memory")
#define PG8_WAIT_L(n) asm volatile("s_waitcnt lgkmcnt(" #n ")" ::: "memory")
#define PG8_BAR __builtin_amdgcn_s_barrier()
#define PG8_SCHED __builtin_amdgcn_sched_barrier(0)
    Unit cur, nxt; int ui = 0;
    if (!S.next(0, cur)) return;
    f32x4 acc[2][2][4][2];
#pragma unroll
    for (int a = 0; a < 2; ++a)
#pragma unroll
        for (int b = 0; b < 2; ++b)
#pragma unroll
            for (int m = 0; m < 4; ++m)
#pragma unroll
                for (int n = 0; n < 2; ++n) acc[a][b][m][n] = (f32x4){0.f, 0.f, 0.f, 0.f};
    bf16x8 At[4][2], B0[2][2], B1[2][2];
    const char* cA = (const char*)g.A + (size_t)cur.pm * tstep; const char* cB = (const char*)g.Bt + (size_t)cur.e * g.estride + (size_t)cur.pn * tstep;
    PG8_STAGE(PG8_SB(0, 0), cB, voffB); PG8_STAGE(PG8_SB(0, 1), cB + hstep, voffB); PG8_STAGE(PG8_SA(0, 0), cA, voffA); PG8_STAGE(PG8_SA(0, 1), cA + hstep, voffA);
    if (wr == 1) PG8_BAR;
    PG8_WAIT_V(2); PG8_BAR;
    PG8_STAGE(PG8_SB(1, 0), cB + kstep, voffB); PG8_STAGE(PG8_SA(1, 0), cA + kstep, voffA); PG8_STAGE(PG8_SB(1, 1), cB + hstep + kstep, voffB);
    PG8_WAIT_V(6); PG8_BAR;
    for (;;) {
        const bool has_next = S.next(ui + 1, nxt);
        const char* nA = has_next ? (const char*)g.A + (size_t)nxt.pm * tstep : cA; const char* nB = has_next ? (const char*)g.Bt + (size_t)nxt.e * g.estride + (size_t)nxt.pn * tstep : cB;
        for (int t = 0; t < nt; t += 2) {
            const bool last = (t == nt - 2);
            const char* a1 = cA + (size_t)(t + 1) * kstep;
            const char* a2 = last ? nA : cA + (size_t)(t + 2) * kstep; const char* b2 = last ? nB : cB + (size_t)(t + 2) * kstep;
            const char* a3 = a2 + kstep; const char* b3 = b2 + kstep;
            PG8_LDB(B0, 0, 0); PG8_LDB(B1, 0, 1); PG8_SCHED; PG8_LDA(At, 0, 0); PG8_STAGE(PG8_SA(1, 1), a1 + hstep, voffA);
            PG8_WAIT_V(8); PG8_WAIT_L(0); PG8_BAR; PG8_MMA(0, 0, At, B0); PG8_MMA(0, 1, At, B1); PG8_BAR; PG8_SCHED;
            PG8_LDA(At, 0, 1); PG8_STAGE(PG8_SB(0, 0), b2, voffB); PG8_STAGE(PG8_SB(0, 1), b2 + hstep, voffB); PG8_STAGE(PG8_SA(0, 0), a2, voffA);
            PG8_WAIT_V(8); PG8_WAIT_L(0); PG8_BAR; PG8_MMA(1, 0, At, B0); PG8_MMA(1, 1, At, B1); PG8_BAR; PG8_SCHED;
            PG8_LDB(B0, 1, 0); PG8_LDB(B1, 1, 1); PG8_SCHED; PG8_LDA(At, 1, 0); PG8_STAGE(PG8_SA(0, 1), a2 + hstep, voffA);
            PG8_WAIT_V(8); PG8_WAIT_L(0); PG8_BAR; PG8_MMA(0, 0, At, B0); PG8_MMA(0, 1, At, B1); PG8_BAR; PG8_SCHED;
            PG8_LDA(At, 1, 1); PG8_STAGE(PG8_SB(1, 0), b3, voffB); PG8_STAGE(PG8_SB(1, 1), b3 + hstep, voffB); PG8_STAGE(PG8_SA(1, 0), a3, voffA);
            PG8_WAIT_V(8); PG8_WAIT_L(0); PG8_BAR; PG8_MMA(1, 0, At, B0); PG8_MMA(1, 1, At, B1); PG8_BAR; PG8_SCHED;
        }
        if (wr == 0) PG8_BAR;
        E(acc, cur, wr, wc, fr, fq);
        if (!has_next) break;
#pragma unroll
        for (int a = 0; a < 2; ++a)
#pragma unroll
            for (int b = 0; b < 2; ++b)
#pragma unroll
                for (int m = 0; m < 4; ++m)
#pragma unroll
                    for (int n = 0; n < 2; ++n) acc[a][b][m][n] = (f32x4){0.f, 0.f, 0.f, 0.f};
        cur = nxt; cA = nA; cB = nB; ++ui;
        if (wr == 1) PG8_BAR;
    }
    PG8_WAIT_V(0);
    PG8_BAR;
#undef PG8_SA
#undef PG8_SB
#undef PG8_STAGE
#undef PG8_LDA
#undef PG8_LDB
#undef PG8_MMA
#undef PG8_WAIT_V
#undef PG8_WAIT_L
#undef PG8_BAR
#undef PG8_SCHED
}
}

struct Args {
    const float* x; const int* positions; const float* norm1_g; const float* w_in;
    const float* lq1; const float* lk1; const float* lq2; const float* lk2;
    const float* diff_g; const float* ret_g; const float* w_o; const float* norm2_g;
    const float* w_router; const float* b_router; const float* w_moe_in; const float* b_moe_in;
    const float* w_moe_out; const float* b_moe_out; const float* norm_f_g;
    float* out; unsigned char* ws; int ph_lo, ph_hi;
};

struct Frame {
    LAS unsigned char* lds;
    int tid, lane, wave, G, bid;
};

template <class RowMap>
__device__ __forceinline__ void transpose_item(const float* W, int K, int N, bf16_t* WT, LAS float* scr, int item, int lane, RowMap rowmap) {
    const int nblk = N / 32, kb = item / nblk, nb = item % nblk, k0 = 64 * kb, n0 = 32 * nb;
#pragma unroll 8
    for (int i = 0; i < 32; ++i) { const int kk = 2 * i + (lane >> 5); scr[kk * 33 + (lane & 31)] = W[(size_t)(k0 + kk) * N + n0 + (lane & 31)]; }
    asm volatile("s_waitcnt lgkmcnt(0)" ::: "memory");
    const int c = lane & 7;
#pragma unroll
    for (int j = 0; j < 4; ++j) { const int n = (lane >> 3) + 8 * j; const LAS float* s = scr + (8 * c) * 33 + n;
        u32x4 o; o.x = pk2(s[0 * 33], s[1 * 33]); o.y = pk2(s[2 * 33], s[3 * 33]); o.z = pk2(s[4 * 33], s[5 * 33]); o.w = pk2(s[6 * 33], s[7 * 33]);
        *(u32x4*)(WT + (size_t)rowmap(n0 + n) * K + k0 + 8 * c) = o; }
    asm volatile("s_waitcnt lgkmcnt(0)" ::: "memory");
}
__device__ __forceinline__ int win_rowmap(int n) {
    const bool isrope = (n < C_DV) || (n >= C_RQ && n < C_RV);
    if (!isrope) return n;
    const int d = n & 63, nn = d >> 5, i = d & 31;
    return (n & ~63) + 32 * (i >> 4) + 8 * ((i >> 2) & 3) + 4 * nn + (i & 3);
}
__device__ __forceinline__ int wmi_rowmap(int n) {
    const int t = n & 1, a = (n >> 1) & 127, tile = n >> 8;
    return 256 * tile + 128 * (a >> 6) + 32 * ((a >> 4) & 3) + 8 * ((a >> 2) & 3) + 4 * t + (a & 3);
}
__device__ __forceinline__ int id_rowmap(int n) { return n; }

__device__ __forceinline__ void p0_prologue(const Frame& F, const Args& a) {
    LAS float* scr = (LAS float*)(F.lds + F.wave * 16384);
    const int gw = F.bid * NWAVES + F.wave, NGW = F.G * NWAVES;
    bf16_t* Wt_in = (bf16_t*)(a.ws + WS_WIN); bf16_t* Wt_o = (bf16_t*)(a.ws + WS_WO); bf16_t* Wt_mi = (bf16_t*)(a.ws + WS_WMI); bf16_t* Wt_mo = (bf16_t*)(a.ws + WS_WMO);
    constexpr int I_IN = (DM / 64) * (PW / 32), I_O = (DM / 64) * (DM / 32), I_MI = (DM / 64) * (2 * FF / 32), I_MO = (FF / 64) * (DM / 32);
    constexpr int NITEMS = I_IN + I_O + NEXP * I_MI + NEXP * I_MO;
    for (int it = gw; it < NITEMS; it += NGW) {
        int r = it;
        if (r < I_IN) { transpose_item(a.w_in, DM, PW, Wt_in, scr, r, F.lane, win_rowmap); continue; } r -= I_IN;
        if (r < I_O) { transpose_item(a.w_o, DM, DM, Wt_o, scr, r, F.lane, id_rowmap); continue; } r -= I_O;
        if (r < NEXP * I_MI) { const int e = r / I_MI; transpose_item(a.w_moe_in + (size_t)e * DM * 2 * FF, DM, 2 * FF, Wt_mi + (size_t)e * 2 * FF * DM, scr, r % I_MI, F.lane, wmi_rowmap); continue; } r -= NEXP * I_MI;
        { const int e = r / I_MO; transpose_item(a.w_moe_out + (size_t)e * FF * DM, FF, DM, Wt_mo + (size_t)e * DM * FF, scr, r % I_MO, F.lane, id_rowmap); }
    }
    bf16_t* XN = (bf16_t*)(a.ws + WS_XN);
    for (int m = gw; m < NTOK; m += NGW) {
        const f32x4* xr = (const f32x4*)(a.x + (size_t)m * DM) + F.lane;
        f32x4 v[4]; float s = 0.f;
#pragma unroll
        for (int j = 0; j < 4; ++j) { v[j] = xr[64 * j]; s += (v[j].x * v[j].x + v[j].y * v[j].y) + (v[j].z * v[j].z + v[j].w * v[j].w); }
        const float r = 1.0f / sqrtf(wave_sum(s) * (1.0f / DM) + RMS_EPS);
        unsigned long long* o8 = (unsigned long long*)(XN + (size_t)m * DM) + F.lane;
#pragma unroll
        for (int j = 0; j < 4; ++j) { const f32x4 g = *((const f32x4*)a.norm1_g + F.lane + 64 * j);
            o8[64 * j] = (unsigned long long)pk2(v[j].x * r * g.x, v[j].y * r * g.y) | ((unsigned long long)pk2(v[j].z * r * g.z, v[j].w * r * g.w) << 32); }
    }
    float* rope = (float*)(a.ws + WS_ROPE);
    for (int m2 = gw; m2 < NTOK / 2; m2 += NGW) {
        const int row = 2 * m2 + (F.lane >> 5), i = F.lane & 31;
        const float inv_freq = 1.0f / powf(10000.0f, (float)(2 * i) / 64.0f);
        const float ang = (float)a.positions[row] * inv_freq;
        float sn, cs; sincosf(ang, &sn, &cs);
        rope[(size_t)row * 64 + i] = cs; rope[(size_t)row * 64 + 32 + i] = sn;
    }
}

__device__ __forceinline__ float ret_log2_gamma(int h) { return log2f(1.0f - exp2f(-5.0f - (float)h)); }
__device__ __forceinline__ void p2_ret_kv(const Frame& F, const Args& a) {
    const bf16_t* PROJ = (const bf16_t*)(a.ws + WS_PROJ); float* KVT = (float*)(a.ws + WS_KVT);
    LAS unsigned char* Kc = F.lds;
    LAS unsigned char* Vc = F.lds + 16384;
    const int lane = F.lane, w = F.wave, hi = lane >> 5;
    for (int u = F.bid; u < NB * 4 * NCH; u += F.G) {
        const int b = u / (4 * NCH), h = (u / NCH) & 3, n = u % NCH;
        const size_t row0 = (size_t)b * SEQ + (size_t)n * 128;
        const float lg = ret_log2_gamma(h);
        __syncthreads();
#pragma unroll
        for (int p = 0; p < 2; ++p) { const int idx = F.tid + p * NTHR, j = idx >> 3, c = idx & 7;
            u32x4 kv = *(const u32x4*)(PROJ + (row0 + j) * PW + C_RK + h * 64 + c * 8);
            const float dec = exp2f(lg * (float)(127 - j));
            u32x4 o; o.x = pk2(bflo(kv.x) * dec, bfhi(kv.x) * dec); o.y = pk2(bflo(kv.y) * dec, bfhi(kv.y) * dec); o.z = pk2(bflo(kv.z) * dec, bfhi(kv.z) * dec); o.w = pk2(bflo(kv.w) * dec, bfhi(kv.w) * dec);
            *(LAS u32x4*)(Kc + j * 128 + c * 16) = o; }
#pragma unroll
        for (int p = 0; p < 4; ++p) { const int idx = F.tid + p * NTHR, j = idx >> 4, c = idx & 15;
            *(LAS u32x4*)(Vc + j * 256 + c * 16) = *(const u32x4*)(PROJ + (row0 + j) * PW + C_RV + h * 128 + c * 8); }
        __syncthreads();
        const int eb = w >> 1, db = w & 1;
        f32x16 acc = {};
        const int rsub = (lane & 15) >> 2, cb = 16 * ((lane >> 4) & 1) + 4 * (lane & 3);
#pragma unroll
        for (int s = 0; s < 8; ++s) {
            const int jlo = 16 * s + 4 * hi + rsub, jhi = jlo + 8;
            const bf16x8 af = cat8(tr_read(Vc + jlo * 256 + (32 * eb + cb) * 2), tr_read(Vc + jhi * 256 + (32 * eb + cb) * 2));
            const bf16x8 bfr = cat8(tr_read(Kc + jlo * 128 + (32 * db + cb) * 2), tr_read(Kc + jhi * 128 + (32 * db + cb) * 2));
            acc = MFMA32(af, bfr, acc);
        }
        float* o = KVT + (size_t)u * 8192;
#pragma unroll
        for (int r = 0; r < 16; ++r) o[(32 * eb + crow(r, hi)) * 64 + 32 * db + (lane & 31)] = acc[r];
    }
}
__device__ __forceinline__ void p3_ret_scan(const Frame& F, const Args& a) {
    const float* KVT = (const float*)(a.ws + WS_KVT); bf16_t* PREVT = (bf16_t*)(a.ws + WS_PREVT);
    for (int g = F.bid * NTHR + F.tid; g < NB * 4 * 8192; g += F.G * NTHR) {
        const int bh = g >> 13, ed = g & 8191, h = bh & 3;
        const float cd = exp2f(ret_log2_gamma(h) * 128.0f);
        float st = 0.f;
        for (int n = 0; n < NCH; ++n) { const size_t idx = ((size_t)(bh * NCH + n) << 13) + ed; PREVT[idx] = (bf16_t)f2bf(st); st = st * cd + KVT[idx]; }
    }
}

__device__ __forceinline__ void attn_unit(const Frame& F, const Args& a, int b, int h, int qb, float lam) {
    const bf16_t* PROJ = (const bf16_t*)(a.ws + WS_PROJ); bf16_t* MIX = (bf16_t*)(a.ws + WS_MIX);
    const int lane = F.lane, w = F.wave, hi = lane >> 5, r32 = lane & 31, br = w >> 2, ib = w & 3;
    const size_t rowb = (size_t)b * SEQ;
    const int q0 = qb * 128 + ib * 32;
    const int NT = 2 * qb + 2;
    bf16x8 qf[4];
    { const bf16_t* qp = PROJ + (rowb + q0 + r32) * PW + C_DQ + h * 128 + br * 64 + hi * 8;
#pragma unroll
      for (int d0 = 0; d0 < 4; ++d0) qf[d0] = *(const bf16x8*)(qp + d0 * 16); }
    f32x16 o[4]; o[0] = f32x16{}; o[1] = f32x16{}; o[2] = f32x16{}; o[3] = f32x16{};
    float mrun = -INFINITY, lrun = 0.f;
    u32x4 kreg[2], vreg[2];
    auto gload = [&](int t) {
#pragma unroll
        for (int p = 0; p < 2; ++p) { const int idx = F.tid + p * NTHR;
            const int c = idx >> 6, key = idx & 63;
            kreg[p] = *(const u32x4*)(PROJ + (rowb + t * 64 + key) * PW + C_DK + h * 128 + c * 8);
            const int key2 = idx >> 4, c2 = idx & 15;
            vreg[p] = *(const u32x4*)(PROJ + (rowb + t * 64 + key2) * PW + C_DV + h * 128 + c2 * 8); }
    };
    auto lstore = [&](int st) {
        LAS unsigned char* Kb = F.lds + st * 32768; LAS unsigned char* Vb = Kb + 16384;
#pragma unroll
        for (int p = 0; p < 2; ++p) { const int idx = F.tid + p * NTHR;
            *(LAS u32x4*)(Kb + idx * 16) = kreg[p];
            const int key2 = idx >> 4, c2 = idx & 15;
            *(LAS u32x4*)(Vb + (c2 >> 2) * 4096 + (key2 >> 4) * 1024 + (key2 & 15) * 64 + (c2 & 3) * 16) = vreg[p]; }
    };
    __syncthreads();
    gload(0); lstore(0);
    __syncthreads();
    for (int t = 0; t < NT; ++t) {
        const int st = t & 1;
        if (t + 1 < NT) gload(t + 1);
        const bool active = (t * 64 <= q0 + 31);
        if (active) {
            const LAS unsigned char* Kb = F.lds + st * 32768; const LAS unsigned char* Vb = Kb + 16384;
            f32x16 p0 = {}, p1 = {};
            const LAS unsigned char* kp = Kb + (br * 8) * 1024 + hi * 1024 + r32 * 16;
#pragma unroll
            for (int d0 = 0; d0 < 4; ++d0) {
                const bf16x8 k0 = *(const LAS bf16x8*)(kp + d0 * 2048), k1 = *(const LAS bf16x8*)(kp + d0 * 2048 + 512);
                p0 = MFMA32(k0, qf[d0], p0); p1 = MFMA32(k1, qf[d0], p1);
            }
            if (t * 64 + 63 > q0) {
                const int qi = q0 + r32;
#pragma unroll
                for (int r = 0; r < 16; ++r) { const int kv = t * 64 + crow(r, hi); if (kv > qi) p0[r] = -INFINITY; if (kv + 32 > qi) p1[r] = -INFINITY; }
            }
            float mx = p0[0];
#pragma unroll
            for (int r = 1; r < 16; ++r) mx = fmaxf(mx, p0[r]);
#pragma unroll
            for (int r = 0; r < 16; ++r) mx = fmaxf(mx, p1[r]);
            mx = fmaxf(mx, __shfl_xor(mx, 32));
            const float mnew = fmaxf(mrun, mx);
            const float f = exp2f(mrun - mnew);
            mrun = mnew; lrun *= f;
#pragma unroll
            for (int d = 0; d < 4; ++d)
#pragma unroll
                for (int r = 0; r < 16; ++r) o[d][r] *= f;
            float ls = 0.f;
#pragma unroll
            for (int r = 0; r < 16; ++r) { p0[r] = exp2f(p0[r] - mnew); p1[r] = exp2f(p1[r] - mnew); ls += p0[r] + p1[r]; }
            lrun += ls;
            bf16x8 pf[4]; pf[0] = pack8(p0, 0); pf[1] = pack8(p0, 8); pf[2] = pack8(p1, 0); pf[3] = pack8(p1, 8);
            const LAS unsigned char* vp = Vb + ((lane >> 4) & 1) * 32 + (lane & 3) * 8 + (4 * hi + ((lane & 15) >> 2)) * 64;
#pragma unroll
            for (int d = 0; d < 4; ++d)
#pragma unroll
                for (int s = 0; s < 4; ++s) {
                    const bf16x8 vf = cat8(tr_read(vp + d * 4096 + s * 1024), tr_read(vp + d * 4096 + s * 1024 + 512));
                    o[d] = MFMA32(vf, pf[s], o[d]);
                }
        }
        if (t + 1 < NT) lstore(st ^ 1);
        __syncthreads();
    }
    lrun += __shfl_xor(lrun, 32);
    const float il = 1.0f / lrun;
    LAS float* cmb = (LAS float*)F.lds + ib * 4096;
    if (br == 1) {
#pragma unroll
        for (int d = 0; d < 4; ++d)
#pragma unroll
            for (int r = 0; r < 16; ++r) cmb[(32 * d + crow(r, hi)) * 32 + r32] = o[d][r] * il;
    }
    __syncthreads();
    if (br == 0) {
        float ss = 0.f;
#pragma unroll
        for (int d = 0; d < 4; ++d)
#pragma unroll
            for (int r = 0; r < 16; ++r) { const float v = o[d][r] * il - lam * cmb[(32 * d + crow(r, hi)) * 32 + r32]; o[d][r] = v; ss += v * v; }
        ss += __shfl_xor(ss, 32);
        const float rn = 0.8f / sqrtf(ss * (1.0f / 128.0f) + RMS_EPS);
        bf16_t* op = MIX + (rowb + q0 + r32) * DM + h * 128;
#pragma unroll
        for (int d = 0; d < 4; ++d)
#pragma unroll
            for (int r = 0; r < 16; ++r) { const int dv = 32 * d + crow(r, hi); op[dv] = (bf16_t)f2bf(o[d][r] * rn * a.diff_g[dv]); }
    }
}
__device__ __forceinline__ void ret_unit(const Frame& F, const Args& a, int item0) {
    const bf16_t* PROJ = (const bf16_t*)(a.ws + WS_PROJ); bf16_t* MIX = (bf16_t*)(a.ws + WS_MIX); const bf16_t* PREVT = (const bf16_t*)(a.ws + WS_PREVT);
    const int lane = F.lane, w = F.wave, hi = lane >> 5, r32 = lane & 31, q4 = w >> 2, ib = w & 3;
    const int item = item0 + q4;
    const int b = item / (4 * NCH), h = (item / NCH) & 3, n = item % NCH;
    const size_t row0 = (size_t)b * SEQ + (size_t)n * 128;
    const float lg = ret_log2_gamma(h);
    LAS unsigned char* Kb = F.lds + q4 * 49152;
    LAS unsigned char* Vb = Kb + 16384;
    const int t4 = F.tid & 255;
    __syncthreads();
#pragma unroll
    for (int p = 0; p < 4; ++p) { const int idx = t4 + p * 256, c = idx >> 7, key = idx & 127;
        *(LAS u32x4*)(Kb + idx * 16) = *(const u32x4*)(PROJ + (row0 + key) * PW + C_RK + h * 64 + c * 8); }
#pragma unroll
    for (int p = 0; p < 8; ++p) { const int idx = t4 + p * 256, j = idx >> 4, c = idx & 15;
        *(LAS u32x4*)(Vb + j * 256 + c * 16) = *(const u32x4*)(PROJ + (row0 + j) * PW + C_RV + h * 128 + c * 8); }
    bf16x8 qf[4];
    { const bf16_t* qp = PROJ + (row0 + ib * 32 + r32) * PW + C_RQ + h * 64 + hi * 8;
#pragma unroll
      for (int d0 = 0; d0 < 4; ++d0) qf[d0] = *(const bf16x8*)(qp + d0 * 16); }
    f32x16 acc[4];
    { const bf16_t* pp = PREVT + (size_t)item * 8192 + (size_t)r32 * 64 + hi * 8;
#pragma unroll
      for (int eb = 0; eb < 4; ++eb) { acc[eb] = f32x16{};
#pragma unroll
          for (int s = 0; s < 4; ++s) { const bf16x8 af = *(const bf16x8*)(pp + eb * 32 * 64 + s * 16); acc[eb] = MFMA32(af, qf[s], acc[eb]); } } }
    const int i = ib * 32 + r32;
    { const float qd = exp2f(lg * (float)(i + 1));
#pragma unroll
      for (int eb = 0; eb < 4; ++eb)
#pragma unroll
          for (int r = 0; r < 16; ++r) acc[eb][r] *= qd; }
    __syncthreads();
    const int rsub = (lane & 15) >> 2, cb = 16 * ((lane >> 4) & 1) + 4 * (lane & 3);
    for (int jb = 0; jb <= ib; ++jb) {
        f32x16 s0 = {};
        const LAS unsigned char* kp = Kb + hi * 2048 + (jb * 32 + r32) * 16;
#pragma unroll
        for (int d0 = 0; d0 < 4; ++d0) { const bf16x8 kf = *(const LAS bf16x8*)(kp + d0 * 4096); s0 = MFMA32(kf, qf[d0], s0); }
#pragma unroll
        for (int r = 0; r < 16; ++r) { const int j = jb * 32 + crow(r, hi); s0[r] = (i >= j) ? s0[r] * exp2f(lg * (float)(i - j)) : 0.f; }
        bf16x8 pf[2]; pf[0] = pack8(s0, 0); pf[1] = pack8(s0, 8);
#pragma unroll
        for (int eb = 0; eb < 4; ++eb)
#pragma unroll
            for (int s = 0; s < 2; ++s) {
                const int jlo = jb * 32 + 16 * s + 4 * hi + rsub, jhi = jlo + 8;
                const bf16x8 vf = cat8(tr_read(Vb + jlo * 256 + (32 * eb + cb) * 2), tr_read(Vb + jhi * 256 + (32 * eb + cb) * 2));
                acc[eb] = MFMA32(vf, pf[s], acc[eb]);
            }
    }
    float ss = 0.f;
#pragma unroll
    for (int eb = 0; eb < 4; ++eb)
#pragma unroll
        for (int r = 0; r < 16; ++r) ss += acc[eb][r] * acc[eb][r];
    ss += __shfl_xor(ss, 32);
    const float rn = 1.0f / sqrtf(ss * (1.0f / 128.0f) + RMS_EPS);
    const bf16_t* gp = PROJ + (row0 + i) * PW + C_RG + h * 128;
    bf16_t* op = MIX + (row0 + i) * DM + 512 + h * 128;
#pragma unroll
    for (int eb = 0; eb < 4; ++eb)
#pragma unroll
        for (int r = 0; r < 16; ++r) { const int e = 32 * eb + crow(r, hi);
            const float g = bf2f(gp[e]); const float sg = g / (1.0f + exp2f(-LOG2E * g));
            op[e] = (bf16_t)f2bf(acc[eb][r] * rn * a.ret_g[h * 128 + e] * sg); }
}
__device__ __forceinline__ void p4_mixers(const Frame& F, const Args& a) {
    float lam;
    { const float p1 = a.lq1[F.lane] * a.lk1[F.lane], p2 = a.lq2[F.lane] * a.lk2[F.lane];
      lam = expf(wave_sum(p1)) - expf(wave_sum(p2)) + 0.2f; }
    const int NU = NB * 4 * 64;
    for (int L = F.bid, round = 0; L < NU; L += F.G, ++round) {
        int rank = L >> 4; const int bh = L & 15;
        int qb = 63 - rank;
        if (F.G == 256 && (round & 1)) { const int lo = (round * 256) >> 4, hi_ = lo + 15; qb = 63 - (lo + hi_ - rank); }
        attn_unit(F, a, bh >> 2, bh & 3, qb, lam);
    }
    for (int u = F.bid; u < NB * 4 * NCH / 2; u += F.G) ret_unit(F, a, 2 * u);
}

__device__ __forceinline__ void p6_router(const Frame& F, const Args& a) {
    const float* X1 = a.out; unsigned* ctl = (unsigned*)(a.ws + WS_CTL); unsigned* TK = (unsigned*)(a.ws + WS_TOPK);
    LAS float* wr = (LAS float*)F.lds;
    for (int i = F.tid; i < DM * NEXP / 4; i += NTHR) ((LAS f32x4*)wr)[i] = ((const f32x4*)a.w_router)[i];
    __syncthreads();
    const int gw = F.bid * NWAVES + F.wave, NGW = F.G * NWAVES, lane = F.lane;
    for (int m = gw; m < NTOK; m += NGW) {
        const f32x4* xr = (const f32x4*)(X1 + (size_t)m * DM) + lane;
        f32x4 v[4]; float s = 0.f;
#pragma unroll
        for (int j = 0; j < 4; ++j) { v[j] = xr[64 * j]; s += (v[j].x * v[j].x + v[j].y * v[j].y) + (v[j].z * v[j].z + v[j].w * v[j].w); }
        const float r2 = 1.0f / sqrtf(wave_sum(s) * (1.0f / DM) + RMS_EPS);
        float lg[32];
#pragma unroll
        for (int e = 0; e < 32; ++e) lg[e] = 0.f;
#pragma unroll
        for (int j = 0; j < 4; ++j) {
            const f32x4 g = *((const f32x4*)a.norm2_g + lane + 64 * j);
            const float hv[4] = {v[j].x * r2 * g.x, v[j].y * r2 * g.y, v[j].z * r2 * g.z, v[j].w * r2 * g.w};
#pragma unroll
            for (int c = 0; c < 4; ++c) {
                const LAS f32x4* wp = (const LAS f32x4*)(wr + (size_t)(4 * lane + 256 * j + c) * 32);
#pragma unroll
                for (int e4 = 0; e4 < 8; ++e4) { const f32x4 wv = wp[e4]; lg[4 * e4] += hv[c] * wv.x; lg[4 * e4 + 1] += hv[c] * wv.y; lg[4 * e4 + 2] += hv[c] * wv.z; lg[4 * e4 + 3] += hv[c] * wv.w; }
                asm volatile("" ::: "memory");
            }
        }
#define RS_STEP(K, NREM) { const bool up = (lane >> (K)) & 1; _Pragma("unroll") for (int q = 0; q < (NREM) / 2; ++q) { \
            const float mine = up ? lg[q + (NREM) / 2] : lg[q], theirs = up ? lg[q] : lg[q + (NREM) / 2]; lg[q] = mine + __shfl_xor(theirs, 1 << (K)); } }
        RS_STEP(0, 32) RS_STEP(1, 16) RS_STEP(2, 8) RS_STEP(3, 4) RS_STEP(4, 2)
#undef RS_STEP
        float val = lg[0] + __shfl_xor(lg[0], 32);
        const int e_own = ((lane & 1) << 4) | ((lane & 2) << 2) | (lane & 4) | ((lane & 8) >> 2) | ((lane & 16) >> 4);
        val += a.b_router[e_own];
        float tv[4]; int ti[4];
        float cur = val;
#pragma unroll
        for (int k = 0; k < 4; ++k) {
            float bv = cur; int bi = e_own;
#pragma unroll
            for (int o = 1; o < 64; o <<= 1) { const float ov = __shfl_xor(bv, o); const int oi = __shfl_xor(bi, o); if (ov > bv || (ov == bv && oi < bi)) { bv = ov; bi = oi; } }
            tv[k] = bv; ti[k] = bi; if (e_own == bi) cur = -INFINITY;
        }
        const float e1 = expf(tv[1] - tv[0]), e2 = expf(tv[2] - tv[0]), e3 = expf(tv[3] - tv[0]);
        const float inv = 1.0f / (1.0f + e1 + e2 + e3);
        if (lane < 4) {
            const int e = lane == 0 ? ti[0] : lane == 1 ? ti[1] : lane == 2 ? ti[2] : ti[3];
            const float gt = (lane == 0 ? 1.0f : lane == 1 ? e1 : lane == 2 ? e2 : e3) * inv;
            const unsigned slot = atomicAdd(ctl + CW_CNT + e, 1u);
            unsigned* t = TK + (size_t)m * 16;
            t[lane] = (unsigned)e; t[4 + lane] = __builtin_bit_cast(unsigned, gt); t[8 + lane] = slot;
            if (lane == 0) t[12] = __builtin_bit_cast(unsigned, r2);
        }
    }
}
__device__ __forceinline__ unsigned expert_offsets(const unsigned* ctl, int lane, unsigned& ntiles) {
    const unsigned c = (lane < 32) ? __hip_atomic_load(ctl + CW_CNT + (lane & 31), __ATOMIC_RELAXED, __HIP_MEMORY_SCOPE_AGENT) : 0u;
    const unsigned t = (c + 255u) >> 8;
    unsigned inc = t;
#pragma unroll
    for (int o = 1; o < 32; o <<= 1) { const unsigned v = __shfl_up(inc, o); if ((lane & 31) >= o) inc += v; }
    ntiles = __shfl(inc, 31);
    return (inc - t) << 8;
}
__device__ __forceinline__ void p7_scatter(const Frame& F, const Args& a) {
    const float* X1 = a.out; const unsigned* ctl = (const unsigned*)(a.ws + WS_CTL); unsigned* TK = (unsigned*)(a.ws + WS_TOPK); bf16_t* XG = (bf16_t*)(a.ws + WS_XG);
    const int gw = F.bid * NWAVES + F.wave, NGW = F.G * NWAVES, lane = F.lane;
    unsigned ntiles; const unsigned myoff = expert_offsets(ctl, lane, ntiles);
    for (int m = gw; m < NTOK; m += NGW) {
        unsigned* t = TK + (size_t)m * 16;
        const float r2 = __builtin_bit_cast(float, t[12]);
        unsigned pos[4];
#pragma unroll
        for (int k = 0; k < 4; ++k) { const unsigned e = t[k], sl = t[8 + k]; pos[k] = __shfl(myoff, (int)e) + sl; }
        const f32x4* xr = (const f32x4*)(X1 + (size_t)m * DM) + lane;
#pragma unroll
        for (int j = 0; j < 4; ++j) { const f32x4 v = xr[64 * j]; const f32x4 g = *((const f32x4*)a.norm2_g + lane + 64 * j);
            const unsigned long long o = (unsigned long long)pk2(v.x * r2 * g.x, v.y * r2 * g.y) | ((unsigned long long)pk2(v.z * r2 * g.z, v.w * r2 * g.w) << 32);
#pragma unroll
            for (int k = 0; k < 4; ++k) *((unsigned long long*)(XG + (size_t)pos[k] * DM) + lane + 64 * j) = o; }
        if (lane < 4) t[8 + lane] = (lane == 0 ? pos[0] : lane == 1 ? pos[1] : lane == 2 ? pos[2] : pos[3]);
    }
}
__device__ __forceinline__ int build_tile_table(const Frame& F, const Args& a) {
    const unsigned* ctl = (const unsigned*)(a.ws + WS_CTL);
    unsigned ntiles; const unsigned myoff = expert_offsets(ctl, F.lane, ntiles);
    LAS unsigned char* tab = F.lds + LDS_MISC;
    const unsigned nextoff = __shfl_down(myoff, 1);
    __syncthreads();
    if (F.wave == 0 && F.lane < 32) {
        const unsigned t0 = myoff >> 8, t1 = (F.lane == 31) ? ntiles : (nextoff >> 8);
        for (unsigned t = t0; t < t1; ++t) tab[t] = (unsigned char)F.lane;
    }
    __syncthreads();
    return (int)ntiles;
}
__device__ __forceinline__ void p10_final(const Frame& F, const Args& a) {
    float* X1 = a.out; const unsigned* TK = (const unsigned*)(a.ws + WS_TOPK); const bf16_t* Y = (const bf16_t*)(a.ws + WS_Y);
    const int gw = F.bid * NWAVES + F.wave, NGW = F.G * NWAVES, lane = F.lane;
    for (int m = gw; m < NTOK; m += NGW) {
        const unsigned* t = TK + (size_t)m * 16;
        float gt[4]; unsigned pos[4];
#pragma unroll
        for (int k = 0; k < 4; ++k) { gt[k] = __builtin_bit_cast(float, t[4 + k]); pos[k] = t[8 + k]; }
        f32x4* xr = (f32x4*)(X1 + (size_t)m * DM) + lane;
        f32x4 v[4]; float s = 0.f;
#pragma unroll
        for (int j = 0; j < 4; ++j) { v[j] = xr[64 * j];
#pragma unroll
            for (int k = 0; k < 4; ++k) { const u32x2 yw = *((const u32x2*)(Y + (size_t)pos[k] * DM) + lane + 64 * j);
                v[j].x += gt[k] * bflo(yw.x); v[j].y += gt[k] * bfhi(yw.x); v[j].z += gt[k] * bflo(yw.y); v[j].w += gt[k] * bfhi(yw.y); }
            s += (v[j].x * v[j].x + v[j].y * v[j].y) + (v[j].z * v[j].z + v[j].w * v[j].w); }
        const float r = 1.0f / sqrtf(wave_sum(s) * (1.0f / DM) + RMS_EPS);
#pragma unroll
        for (int j = 0; j < 4; ++j) { const f32x4 g = *((const f32x4*)a.norm_f_g + lane + 64 * j); xr[64 * j] = v[j] * r * g; }
    }
}

constexpr int NPHASE = 11;
__global__ void __launch_bounds__(NTHR, 2) fwd_kernel(Args a) {
    extern __shared__ __attribute__((aligned(16))) unsigned char lds_raw[];
    cg::grid_group grid = cg::this_grid();
    Frame F; F.lds = (LAS unsigned char*)lds_raw; F.tid = threadIdx.x; F.lane = F.tid & 63; F.wave = __builtin_amdgcn_readfirstlane(F.tid >> 6); F.G = gridDim.x; F.bid = blockIdx.x;
    unsigned char* ws = a.ws;
    const int lo = a.ph_lo, hi = a.ph_hi;
#ifndef PHMASK
#define PHMASK 0x7ff
#endif
#define IN(k) (((PHMASK >> (k)) & 1) && lo <= (k) && (k) < hi)
#define SEAM(k) do { if (IN(k) && IN((k) + 1)) grid.sync(); } while (0)
    if (IN(0)) p0_prologue(F, a);
    SEAM(0);
    if (IN(1)) {
        pg8::Gemm g{(const bf16_t*)(ws + WS_XN), (const bf16_t*)(ws + WS_WIN), DM, 0};
        pg8::StaticOrder S; S.init(NTOK, PW, F.G, F.bid);
        pg8::EpiProj E{(bf16_t*)(ws + WS_PROJ), (const float*)(ws + WS_ROPE)};
        pg8::gemm_phase(F.lds, g, S, E);
    }
    SEAM(1);
    if (IN(2)) p2_ret_kv(F, a);
    SEAM(2);
    if (IN(3)) p3_ret_scan(F, a);
    SEAM(3);
    if (IN(4)) p4_mixers(F, a);
    SEAM(4);
    if (IN(5)) {
        pg8::Gemm g{(const bf16_t*)(ws + WS_MIX), (const bf16_t*)(ws + WS_WO), DM, 0};
        pg8::StaticOrder S; S.init(NTOK, DM, F.G, F.bid);
        pg8::EpiRes E{a.x, a.out};
        pg8::gemm_phase(F.lds, g, S, E);
    }
    SEAM(5);
    if (IN(6)) p6_router(F, a);
    SEAM(6);
    if (IN(7)) p7_scatter(F, a);
    SEAM(7);
    if (IN(8)) {
        const int ntiles = build_tile_table(F, a);
        pg8::Gemm g{(const bf16_t*)(ws + WS_XG), (const bf16_t*)(ws + WS_WMI), DM, (size_t)2 * FF * DM * 2};
        pg8::GroupedOrder S{ntiles, 8, ntiles * 8, F.G, F.bid, F.lds + LDS_MISC};
        pg8::EpiSwiglu E{(bf16_t*)(ws + WS_ACT), a.b_moe_in};
        pg8::gemm_phase(F.lds, g, S, E);
    }
    SEAM(8);
    if (IN(9)) {
        const int ntiles = build_tile_table(F, a);
        pg8::Gemm g{(const bf16_t*)(ws + WS_ACT), (const bf16_t*)(ws + WS_WMO), FF, (size_t)DM * FF * 2};
        pg8::GroupedOrder S{ntiles, 4, ntiles * 4, F.G, F.bid, F.lds + LDS_MISC};
        pg8::EpiY E{(bf16_t*)(ws + WS_Y), a.b_moe_out};
        pg8::gemm_phase(F.lds, g, S, E);
    }
    SEAM(9);
    if (IN(10)) p10_final(F, a);
#undef IN
#undef SEAM
}

#ifndef N_LAUNCHES
#define N_LAUNCHES 1
#endif
extern "C" void kernel_launch(void* const* d_in, const int* in_sizes, int n_in, void* d_out, int out_size, void* d_ws, size_t ws_size, hipStream_t stream) {
    static int grid = 0;
    if (grid == 0) {
        if (n_in != 19 || out_size != NTOK * DM || ws_size < WS_END) { fprintf(stderr, "kernel_launch: unexpected shapes (n_in %d out %d ws %zu)\n", n_in, out_size, ws_size); grid = -1; return; }
        int dev = 0, cus = 0, per_cu = 0;
        if (hipGetDevice(&dev) != hipSuccess || hipDeviceGetAttribute(&cus, hipDeviceAttributeMultiprocessorCount, dev) != hipSuccess) { grid = -1; return; }
        if (hipFuncSetAttribute((const void*)fwd_kernel, hipFuncAttributeMaxDynamicSharedMemorySize, LDS_BYTES) != hipSuccess) { fprintf(stderr, "kernel_launch: hipFuncSetAttribute failed\n"); grid = -1; return; }
        if (hipOccupancyMaxActiveBlocksPerMultiprocessor(&per_cu, (const void*)fwd_kernel, NTHR, LDS_BYTES) != hipSuccess || per_cu < 1) { fprintf(stderr, "kernel_launch: occupancy query says %d\n", per_cu); grid = -1; return; }
        grid = cus;
    }
    if (grid < 0) return;
    (void)hipMemsetAsync((char*)d_ws + WS_CTL, 0, CTL_ZERO_BYTES, stream);
    Args a{};
    a.x = (const float*)d_in[0]; a.positions = (const int*)d_in[1]; a.norm1_g = (const float*)d_in[2]; a.w_in = (const float*)d_in[3];
    a.lq1 = (const float*)d_in[4]; a.lk1 = (const float*)d_in[5]; a.lq2 = (const float*)d_in[6]; a.lk2 = (const float*)d_in[7];
    a.diff_g = (const float*)d_in[8]; a.ret_g = (const float*)d_in[9]; a.w_o = (const float*)d_in[10]; a.norm2_g = (const float*)d_in[11];
    a.w_router = (const float*)d_in[12]; a.b_router = (const float*)d_in[13]; a.w_moe_in = (const float*)d_in[14]; a.b_moe_in = (const float*)d_in[15];
    a.w_moe_out = (const float*)d_in[16]; a.b_moe_out = (const float*)d_in[17]; a.norm_f_g = (const float*)d_in[18];
    a.out = (float*)d_out; a.ws = (unsigned char*)d_ws;
    if (N_LAUNCHES == 1) {
        a.ph_lo = 0; a.ph_hi = NPHASE;
        void* args[] = {&a};
        hipError_t e = hipLaunchCooperativeKernel((const void*)fwd_kernel, dim3(grid), dim3(NTHR), args, LDS_BYTES, stream);
        if (e != hipSuccess) fprintf(stderr, "cooperative launch failed: %s\n", hipGetErrorString(e));
    } else {
        for (int p = 0; p < NPHASE; ++p) {
            a.ph_lo = p; a.ph_hi = p + 1;
            void* args[] = {&a};
            hipError_t e = hipLaunchCooperativeKernel((const void*)fwd_kernel, dim3(grid), dim3(NTHR), args, LDS_BYTES, stream);
            if (e != hipSuccess) { fprintf(stderr, "cooperative launch %d failed: %s\n", p, hipGetErrorString(e)); break; }
        }
    }
}
```

```cpp
#include <hip/hip_runtime.h>
#include <hip/hip_cooperative_groups.h>
#include <cstdio>
#include <cstdint>
namespace cg = cooperative_groups;
#ifndef TIMING_A
#define TIMING_A -1
#endif
#ifndef TIMING_B
#define TIMING_B -1
#endif
#ifndef DOUBLE_MASK
#define DOUBLE_MASK 0
#endif

#define LAS __attribute__((address_space(3)))
typedef unsigned short bf16_t;
typedef short bf16x8 __attribute__((ext_vector_type(8)));
typedef short s16x4 __attribute__((ext_vector_type(4)));
typedef float f32x4 __attribute__((ext_vector_type(4)));
typedef float f32x2 __attribute__((ext_vector_type(2)));
typedef float f32x16 __attribute__((ext_vector_type(16)));
typedef unsigned u32x4 __attribute__((ext_vector_type(4)));
typedef unsigned u32x2 __attribute__((ext_vector_type(2)));

constexpr int NB = 4, SEQ = 8192, DM = 1024, NTOK = NB * SEQ;
constexpr int PW = 3072;
constexpr int C_DQ = 0, C_DK = 512, C_DV = 1024, C_RQ = 1536, C_RK = 1792, C_RV = 2048, C_RG = 2560;
constexpr int NEXP = 32, TOPK = 4, FF = 1024;
constexpr int NCH = SEQ / 128;
constexpr int MAXTILES = (NTOK * TOPK) / 256 + NEXP;
constexpr float RMS_EPS = 1e-5f;
constexpr float LOG2E = 1.4426950408889634f;
constexpr float QSCALE = 0.125f * LOG2E;

constexpr size_t MiB = 1u << 20;
constexpr size_t WS_CTL = 0, CTL_ZERO_BYTES = 32768;
constexpr int CW_BAR = 4096;
constexpr size_t WS_ROWLIST = 131072;
constexpr size_t WS_HIST = 65536;
constexpr size_t WS_WIN = 2 * MiB;
constexpr size_t WS_WO = 8 * MiB;
constexpr size_t WS_WMI = 10 * MiB;
constexpr size_t WS_WMO = 138 * MiB;
constexpr size_t WS_ROPE = 202 * MiB;
constexpr size_t WS_TOPK = 210 * MiB;
constexpr size_t WS_A = 212 * MiB;
constexpr size_t WS_XN = WS_A, WS_PROJ = WS_A + 64 * MiB, WS_H2 = WS_A, WS_Y = WS_A;
constexpr size_t WS_B = 484 * MiB;
constexpr size_t WS_MIX = WS_B, WS_KVT = WS_B + 64 * MiB, WS_PREVT = WS_B + 96 * MiB, WS_ACT = WS_B;
constexpr size_t WS_X1B = 628 * MiB;
constexpr size_t WS_END = 756 * MiB;
constexpr int CW_CNT = 0;

constexpr int LDS_BYTES = 155648;
constexpr int LDS_MISC = 131072;
constexpr int LDS_ROWTAB = LDS_MISC + 1024, ROWTAB_UNITS = 18;
constexpr int NTHR = 512, NWAVES = 8;

__device__ __forceinline__ unsigned f2bf(float f) { unsigned u = __builtin_bit_cast(unsigned, f); return (u + 0x7fffu + ((u >> 16) & 1u)) >> 16; }
__device__ __forceinline__ unsigned pk2(float lo, float hi) { return f2bf(lo) | (f2bf(hi) << 16); }
__device__ __forceinline__ float bf2f(unsigned short b) { return __builtin_bit_cast(float, (unsigned)b << 16); }
__device__ __forceinline__ float bflo(unsigned w) { return __builtin_bit_cast(float, w << 16); }
__device__ __forceinline__ float bfhi(unsigned w) { return __builtin_bit_cast(float, w & 0xffff0000u); }
__device__ __forceinline__ float wave_sum(float v) {
#pragma unroll
    for (int o = 1; o < 64; o <<= 1) v += __shfl_xor(v, o);
    return v;
}
__device__ __forceinline__ int crow(int r, int hi) { return (r & 3) + 8 * (r >> 2) + 4 * hi; }
__device__ __forceinline__ s16x4 tr_read(const LAS unsigned char* p) {
    typedef short v4i16_t __attribute__((ext_vector_type(4)));
    return __builtin_bit_cast(s16x4, __builtin_amdgcn_ds_read_tr16_b64_v4i16((LAS v4i16_t*)p));
}
__device__ __forceinline__ bf16x8 cat8(s16x4 lo, s16x4 hi) { return (bf16x8){lo[0], lo[1], lo[2], lo[3], hi[0], hi[1], hi[2], hi[3]}; }
__device__ __forceinline__ bf16x8 pack8(const f32x16& p, int b) {
    u32x4 w; w.x = pk2(p[b], p[b + 1]); w.y = pk2(p[b + 2], p[b + 3]); w.z = pk2(p[b + 4], p[b + 5]); w.w = pk2(p[b + 6], p[b + 7]);
    return __builtin_bit_cast(bf16x8, w);
}
#define MFMA32(a, b, c) __builtin_amdgcn_mfma_f32_32x32x16_bf16((a), (b), (c), 0, 0, 0)
typedef int v8i __attribute__((ext_vector_type(8)));
__device__ __forceinline__ unsigned pk4_fp8(float a, float b, float c, float d) { int w = 0; w = __builtin_amdgcn_cvt_pk_fp8_f32(a, b, w, false); w = __builtin_amdgcn_cvt_pk_fp8_f32(c, d, w, true); return (unsigned)w; }
constexpr float W8_SCALE = 32.0f;
constexpr float ACT8_SCALE = 4.0f;

namespace pg8 {
constexpr int BM = 256, BK = 64, HALF = 128, HTB = HALF * BK * 2, STAGE_BYTES = 8 * HTB, NXCD = 8;
__host__ __device__ __forceinline__ int lds_byte(int r, int c) { const int st = (r >> 4) * 2 + (c >> 5), rr = r & 15, cc = c & 31, ob = rr * 64 + cc * 2; return st * 1024 + (ob ^ (((ob >> 9) & 1) << 5)); }
__host__ __device__ __forceinline__ void stage_rc(int b, int& R, int& C) { const int st = b / 1024, sb = b % 1024, swz = sb ^ (((sb >> 9) & 1) << 5); R = (st >> 1) * 16 + swz / 64; C = (st & 1) * 32 + (swz % 64) / 2; }
__host__ __device__ __forceinline__ int g8(int k) { return k ^ ((k >= 2 && k <= 5) ? 2 : 0); }
__host__ __device__ __forceinline__ int lds_byte8(int r, int s) { return (r >> 4) * 2048 + (r & 15) * 128 + ((s ^ g8((r & 15) >> 1)) << 4); }
__host__ __device__ __forceinline__ void stage_rc8(int b, int& R, int& CB) { const int blk = b / 2048, rr = (b % 2048) / 128, sl = (b % 128) / 16; R = blk * 16 + rr; CB = (sl ^ g8(rr >> 1)) * 16; }
__host__ __device__ __forceinline__ int perm32(int rho) { const int n = rho >> 4, i = rho & 15; return 8 * (i >> 2) + 4 * n + (i & 3); }

struct Unit { int pm, pn, e; };
struct Gemm { const void* A; const void* Bt; int K; size_t estride; };

struct StaticOrder {
    int nM, nN, nwg, G, c, rep;
    __device__ void init(int M, int N, int G_, int c_, int rep_ = 1) { nM = M / BM; nN = N / BM; nwg = nM * nN; G = G_; c = c_; rep = rep_; }
    __device__ bool next(int i, Unit& u) const {
        const long L = (long)i * G + c; if (L >= (long)nwg * rep) return false;
        int wgid = (int)(L >= nwg ? L - nwg : L); { const int q = nwg / NXCD, r = nwg % NXCD, xcd = wgid % NXCD, off = wgid / NXCD; wgid = (xcd < r ? xcd * (q + 1) : r * (q + 1) + (xcd - r) * q) + off; }
        const int nig = 8 * nN, gid = wgid / nig, fm = gid * 8, gsz = (nM - fm) < 8 ? (nM - fm) : 8;
        u.pm = fm + ((wgid % nig) % gsz); u.pn = (wgid % nig) / gsz; u.e = 0; return true;
    }
};
struct GroupedOrder {
    int ntiles, nN, nwg, G, c; const LAS unsigned char* tile_e; int rep;
    __device__ bool next(int i, Unit& u) const {
        const long L = (long)i * G + c; if (L >= (long)nwg * rep) return false;
        int wgid = (int)(L >= nwg ? L - nwg : L); { const int q = nwg / NXCD, r = nwg % NXCD, xcd = wgid % NXCD, off = wgid / NXCD; wgid = (xcd < r ? xcd * (q + 1) : r * (q + 1) + (xcd - r) * q) + off; }
        u.pm = wgid / nN; u.pn = wgid % nN; u.e = __builtin_amdgcn_readfirstlane((int)tile_e[u.pm]); return true;
    }
};

__device__ __forceinline__ unsigned cvt_pk_bf16(float lo, float hi) { unsigned r; asm volatile("v_cvt_pk_bf16_f32 %0, %1, %2" : "=v"(r) : "v"(lo), "v"(hi)); return r; }

struct EpiProj {
    static constexpr bool PERM = true;
    bf16_t* O; const float* rope;
    __device__ __forceinline__ void operator()(const f32x4 (&acc)[2][2][4][2], const Unit& u, int wr, int wc, int fr, int fq) const {
        const int pn = u.pn;
        const bool isrope = (pn < 4) || pn == 6 || pn == 7;
        const float sc = (pn < 2) ? QSCALE : (pn == 7 ? 0.125f : 1.0f);
        const int row0 = u.pm * BM + wr * 64 + fr, col0 = pn * BM + wc * 32 + 8 * fq, ri = 16 * (wc & 1) + 4 * fq;
#pragma unroll
        for (int ai = 0; ai < 2; ++ai)
#pragma unroll
            for (int m = 0; m < 4; ++m) {
                const int row = row0 + ai * HALF + m * 16;
                bf16_t* rowp = O + (size_t)row * PW + col0;
                f32x4 cs = (f32x4){1.f, 1.f, 1.f, 1.f}, sn = (f32x4){0.f, 0.f, 0.f, 0.f};
                if (isrope) { cs = *(const f32x4*)(rope + (size_t)row * 64 + ri); sn = *(const f32x4*)(rope + (size_t)row * 64 + 32 + ri); }
#pragma unroll
                for (int bj = 0; bj < 2; ++bj) {
                    const f32x4 a0 = acc[ai][bj][m][0], a1 = acc[ai][bj][m][1];
                    f32x4 v0 = (a0 * cs - a1 * sn) * sc, v1 = (a1 * cs + a0 * sn) * sc;
                    u32x4 w; w.x = cvt_pk_bf16(v0[0], v0[1]); w.y = cvt_pk_bf16(v0[2], v0[3]); w.z = cvt_pk_bf16(v1[0], v1[1]); w.w = cvt_pk_bf16(v1[2], v1[3]);
                    *(u32x4*)(rowp + bj * HALF) = w;
                }
                asm volatile("" ::: "memory");
            }
    }
};
struct EpiRes {
    static constexpr bool PERM = true;
    const float* X; bf16_t* O;
    __device__ __forceinline__ void operator()(const f32x4 (&acc)[2][2][4][2], const Unit& u, int wr, int wc, int fr, int fq) const {
        const int row0 = u.pm * BM + wr * 64 + fr, col0 = u.pn * BM + wc * 32 + 8 * fq;
#pragma unroll
        for (int ai = 0; ai < 2; ++ai)
#pragma unroll
            for (int m = 0; m < 4; ++m) {
                const size_t off = (size_t)(row0 + ai * HALF + m * 16) * DM + col0;
#pragma unroll
                for (int bj = 0; bj < 2; ++bj) { const f32x4 x0 = __builtin_nontemporal_load((const f32x4*)(X + off + bj * HALF)), x1 = __builtin_nontemporal_load((const f32x4*)(X + off + bj * HALF + 4));
                    const f32x4 v0 = x0 + acc[ai][bj][m][0], v1 = x1 + acc[ai][bj][m][1];
                    u32x4 w; w.x = cvt_pk_bf16(v0[0], v0[1]); w.y = cvt_pk_bf16(v0[2], v0[3]); w.z = cvt_pk_bf16(v1[0], v1[1]); w.w = cvt_pk_bf16(v1[2], v1[3]);
                    *(u32x4*)(O + off + bj * HALF) = w; }
                if (m & 1) asm volatile("" ::: "memory");
            }
    }
};
struct EpiSwiglu {
    static constexpr bool PERM = true;
    unsigned char* O; const float* bias;
    __device__ __forceinline__ void operator()(const f32x4 (&acc)[2][2][4][2], const Unit& u, int wr, int wc, int fr, int fq) const {
        const int row0 = u.pm * BM + wr * 64 + fr, a0 = u.pn * 128 + wc * 32 + 8 * fq;
        f32x4 bg[2], bl[2];
        { const float* bp = bias + (size_t)u.e * 2048 + 2 * a0;
#pragma unroll
          for (int n = 0; n < 2; ++n) { const f32x4 t0 = *(const f32x4*)(bp + 8 * n), t1 = *(const f32x4*)(bp + 8 * n + 4);
              bg[n] = (f32x4){t0[0], t0[2], t1[0], t1[2]}; bl[n] = (f32x4){t0[1], t0[3], t1[1], t1[3]}; } }
#pragma unroll
        for (int ai = 0; ai < 2; ++ai)
#pragma unroll
            for (int m = 0; m < 4; ++m) {
                unsigned char* rowp = O + (size_t)(row0 + ai * HALF + m * 16) * FF + a0;
                u32x2 w;
#pragma unroll
                for (int n = 0; n < 2; ++n) {
                    const f32x4 ga = acc[ai][0][m][n], la = acc[ai][1][m][n];
                    f32x2 o2[2];
#pragma unroll
                    for (int p = 0; p < 2; ++p) {
                        f32x2 g = (f32x2){ga[2 * p], ga[2 * p + 1]} * (1.0f / W8_SCALE) + (f32x2){bg[n][2 * p], bg[n][2 * p + 1]};
                        f32x2 l = (f32x2){la[2 * p], la[2 * p + 1]} * (1.0f / W8_SCALE) + (f32x2){bl[n][2 * p], bl[n][2 * p + 1]};
                        g.x = fminf(g.x, 7.0f); g.y = fminf(g.y, 7.0f);
                        l.x = __builtin_amdgcn_fmed3f(l.x, -7.0f, 7.0f); l.y = __builtin_amdgcn_fmed3f(l.y, -7.0f, 7.0f);
                        const f32x2 t = g * (-1.702f * LOG2E);
                        f32x2 e; e.x = __builtin_amdgcn_exp2f(t.x); e.y = __builtin_amdgcn_exp2f(t.y);
                        const f32x2 d = e + 1.0f;
                        f32x2 r; r.x = __builtin_amdgcn_rcpf(d.x); r.y = __builtin_amdgcn_rcpf(d.y);
                        o2[p] = (g * r) * (l * ACT8_SCALE + ACT8_SCALE);
                    }
                    w[n] = pk4_fp8(o2[0].x, o2[0].y, o2[1].x, o2[1].y);
                }
                *(u32x2*)rowp = w;
                asm volatile("" ::: "memory");
            }
    }
};
struct EpiY {
    static constexpr bool PERM = true;
    unsigned char* O; const float* bias;
    __device__ __forceinline__ void operator()(const f32x4 (&acc)[2][2][4][2], const Unit& u, int wr, int wc, int fr, int fq) const {
        const int row0 = u.pm * BM + wr * 64 + fr, col0 = u.pn * BM + wc * 32 + 8 * fq;
        constexpr float SC = 1.0f / (W8_SCALE * ACT8_SCALE);
        f32x4 bv[2][2];
#pragma unroll
        for (int bj = 0; bj < 2; ++bj)
#pragma unroll
            for (int n = 0; n < 2; ++n) bv[bj][n] = *(const f32x4*)(bias + (size_t)u.e * DM + col0 + bj * HALF + 4 * n);
#pragma unroll
        for (int ai = 0; ai < 2; ++ai)
#pragma unroll
            for (int m = 0; m < 4; ++m) {
                unsigned char* rowp = O + (size_t)(row0 + ai * HALF + m * 16) * DM + col0;
#pragma unroll
                for (int bj = 0; bj < 2; ++bj) {
                    const f32x4 v0 = acc[ai][bj][m][0] * SC + bv[bj][0], v1 = acc[ai][bj][m][1] * SC + bv[bj][1];
                    u32x2 w; w.x = pk4_fp8(v0[0], v0[1], v0[2], v0[3]); w.y = pk4_fp8(v1[0], v1[1], v1[2], v1[3]);
                    *(u32x2*)(rowp + bj * HALF) = w;
                }
                asm volatile("" ::: "memory");
            }
    }
};

template <int ES, bool GATHER, class Epi, class Sched>
__device__ __forceinline__ void gemm_phase(LAS unsigned char* lds, const Gemm g, const Sched& S, const Epi& E) {
    int tid = threadIdx.x; asm volatile("" : "+v"(tid));
    const int wid = __builtin_amdgcn_readfirstlane(tid >> 6), lane = tid & 63, wr = wid >> 2, wc = wid & 3, fr = lane & 15, fq = lane >> 4;
    const int KB = g.K * ES, nt = KB / (BK * 2);
    unsigned voffA[2], voffB[2];
#pragma unroll
    for (int i = 0; i < 2; ++i) { int R, CB; if constexpr (ES == 2) { stage_rc(tid * 16 + i * 8192, R, CB); CB *= 2; } else stage_rc8(tid * 16 + i * 8192, R, CB);
        const int Rb = Epi::PERM ? ((R & ~31) + perm32(R & 31)) : R;
        voffA[i] = (unsigned)(R * KB + CB); voffB[i] = (unsigned)(Rb * KB + CB); }
    const size_t kstep = (size_t)(BK * 2);
    const size_t hstep = (size_t)HALF * KB;
    const size_t tstep = 2 * hstep;
    const unsigned ldsw = (unsigned)wid * 1024u;
    const int aoff = (ES == 2) ? lds_byte(wr * 64 + fr, fq * 8) : lds_byte8(wr * 64 + fr, 2 * fq), boff = (ES == 2) ? lds_byte(wc * 32 + fr, fq * 8) : lds_byte8(wc * 32 + fr, 2 * fq);
    const int aoff2 = lds_byte8(wr * 64 + fr, 2 * fq + 1), boff2 = lds_byte8(wc * 32 + fr, 2 * fq + 1);
    const int mx_one = 0x7f7f7f7f;
#define PG8_SA(b, h) (((b) * 2 + (h)) * HTB)
#define PG8_SB(b, h) ((4 + (b) * 2 + (h)) * HTB)
#define PG8_STAGE(bufoff, gbase, voff) do { _Pragma("unroll") for (int _i = 0; _i < 2; ++_i) \
        __builtin_amdgcn_global_load_lds((const unsigned*)((const char*)(gbase) + (voff)[_i]), (LAS unsigned*)(lds + (bufoff) + ldsw + _i * 8192), 16, 0, 0); } while (0)
    unsigned vA0[2], vA1[2], nA0[2], nA1[2];
    const LAS unsigned* rtab = (const LAS unsigned*)(lds + LDS_ROWTAB);
#define PG8_ROWS(ui_, d0, d1) do { _Pragma("unroll") for (int _i = 0; _i < 2; ++_i) { int R_, C_; if constexpr (ES == 2) { stage_rc(tid * 16 + _i * 8192, R_, C_); C_ *= 2; } else stage_rc8(tid * 16 + _i * 8192, R_, C_); \
        d0[_i] = rtab[(ui_) * 256 + R_] + (unsigned)C_; d1[_i] = rtab[(ui_) * 256 + 128 + R_] + (unsigned)C_; } } while (0)
#define PG8_STGA(bufoff, ptr, koff, h, nx) do { if constexpr (GATHER) { PG8_STAGE(bufoff, (const char*)g.A + (koff), (nx) ? ((h) ? nA1 : nA0) : ((h) ? vA1 : vA0)); } \
        else { PG8_STAGE(bufoff, (ptr) + (h) * hstep, voffA); } } while (0)
#define PG8_CAT8(lo, hi) __builtin_bit_cast(v8i, __builtin_shufflevector((lo), (hi), 0, 1, 2, 3, 4, 5, 6, 7))
#define PG8_LDA(dst, b, h) do { if constexpr (ES == 2) { _Pragma("unroll") for (int m = 0; m < 4; ++m) _Pragma("unroll") for (int k = 0; k < 2; ++k) dst[m][k] = *(const LAS bf16x8*)(lds + PG8_SA(b, h) + aoff + m * 2048 + k * 1024); } \
        else { _Pragma("unroll") for (int m = 0; m < 4; ++m) dst##8[m] = PG8_CAT8(*(const LAS u32x4*)(lds + PG8_SA(b, h) + aoff + m * 2048), *(const LAS u32x4*)(lds + PG8_SA(b, h) + aoff2 + m * 2048)); } } while (0)
#define PG8_LDB(dst, b, h) do { if constexpr (ES == 2) { _Pragma("unroll") for (int n = 0; n < 2; ++n) _Pragma("unroll") for (int k = 0; k < 2; ++k) dst[n][k] = *(const LAS bf16x8*)(lds + PG8_SB(b, h) + boff + n * 2048 + k * 1024); } \
        else { _Pragma("unroll") for (int n = 0; n < 2; ++n) dst##8[n] = PG8_CAT8(*(const LAS u32x4*)(lds + PG8_SB(b, h) + boff + n * 2048), *(const LAS u32x4*)(lds + PG8_SB(b, h) + boff2 + n * 2048)); } } while (0)
#define PG8_MMA(ai, bj, At, Bt) do { __builtin_amdgcn_s_setprio(1); \
        if constexpr (ES == 2) { _Pragma("unroll") for (int m = 0; m < 4; ++m) _Pragma("unroll") for (int n = 0; n < 2; ++n) _Pragma("unroll") for (int k = 0; k < 2; ++k) \
            acc[ai][bj][m][n] = __builtin_amdgcn_mfma_f32_16x16x32_bf16(Bt[n][k], At[m][k], acc[ai][bj][m][n], 0, 0, 0); } \
        else { _Pragma("unroll") for (int m = 0; m < 4; ++m) _Pragma("unroll") for (int n = 0; n < 2; ++n) \
            asm volatile("v_mfma_scale_f32_16x16x128_f8f6f4 %0, %1, %2, %0, %3, %3 op_sel_hi:[0,0,0]" : "+v"(acc[ai][bj][m][n]) : "v"(Bt##8[n]), "v"(At##8[m]), "v"(mx_one)); } \
        __builtin_amdgcn_s_setprio(0); } while (0)
#define PG8_WAIT_V(n) asm volatile("s_waitcnt vmcnt(" #n ")" ::: "memory")
#define PG8_WAIT_L(n) asm volatile("s_waitcnt lgkmcnt(" #n ")" ::: "memory")
#define PG8_BAR __builtin_amdgcn_s_barrier()
#define PG8_SCHED __builtin_amdgcn_sched_barrier(0)
    Unit cur, nxt; int ui = 0;
    if (!S.next(0, cur)) return;
    f32x4 acc[2][2][4][2];
#pragma unroll
    for (int a = 0; a < 2; ++a)
#pragma unroll
        for (int b = 0; b < 2; ++b)
#pragma unroll
            for (int m = 0; m < 4; ++m)
#pragma unroll
                for (int n = 0; n < 2; ++n) acc[a][b][m][n] = (f32x4){0.f, 0.f, 0.f, 0.f};
    bf16x8 At[4][2], B0[2][2], B1[2][2];
    v8i At8[4], B08[2], B18[2];
    const char* cA = (const char*)g.A + (size_t)cur.pm * tstep; const char* cB = (const char*)g.Bt + (size_t)cur.e * g.estride + (size_t)cur.pn * tstep;
    if constexpr (GATHER) { PG8_ROWS(0, vA0, vA1); }
    PG8_STAGE(PG8_SB(0, 0), cB, voffB); PG8_STAGE(PG8_SB(0, 1), cB + hstep, voffB); PG8_STGA(PG8_SA(0, 0), cA, 0, 0, false); PG8_STGA(PG8_SA(0, 1), cA, 0, 1, false);
    if (wr == 1) PG8_BAR;
    PG8_WAIT_V(2); PG8_BAR;
    PG8_STAGE(PG8_SB(1, 0), cB + kstep, voffB); PG8_STGA(PG8_SA(1, 0), cA + kstep, kstep, 0, false); PG8_STAGE(PG8_SB(1, 1), cB + hstep + kstep, voffB);
    PG8_WAIT_V(6); PG8_BAR;
    for (;;) {
        const bool has_next = S.next(ui + 1, nxt);
        if constexpr (GATHER) { if (has_next) { PG8_ROWS(ui + 1, nA0, nA1); } else { _Pragma("unroll") for (int _i = 0; _i < 2; ++_i) { nA0[_i] = vA0[_i]; nA1[_i] = vA1[_i]; } } }
        const char* nA = has_next ? (const char*)g.A + (size_t)nxt.pm * tstep : cA; const char* nB = has_next ? (const char*)g.Bt + (size_t)nxt.e * g.estride + (size_t)nxt.pn * tstep : cB;
#pragma nounroll
        for (int t = 0; t < nt; t += 2) {
            asm volatile("" : "+v"(voffA[0]), "+v"(voffA[1]), "+v"(voffB[0]), "+v"(voffB[1]));
            const bool last = (t == nt - 2);
            const char* a1 = cA + (size_t)(t + 1) * kstep;
            const char* a2 = last ? nA : cA + (size_t)(t + 2) * kstep; const char* b2 = last ? nB : cB + (size_t)(t + 2) * kstep;
            const char* a3 = a2 + kstep; const char* b3 = b2 + kstep;
            const size_t k1 = (size_t)(t + 1) * kstep, k2 = last ? (size_t)0 : (size_t)(t + 2) * kstep, k3 = k2 + kstep;
            PG8_LDB(B0, 0, 0); PG8_LDB(B1, 0, 1); PG8_SCHED; PG8_LDA(At, 0, 0); PG8_STGA(PG8_SA(1, 1), a1, k1, 1, false);
            PG8_WAIT_V(8); PG8_WAIT_L(0); PG8_BAR; PG8_MMA(0, 0, At, B0); PG8_MMA(0, 1, At, B1); PG8_BAR; PG8_SCHED;
            PG8_LDA(At, 0, 1); PG8_STAGE(PG8_SB(0, 0), b2, voffB); PG8_STAGE(PG8_SB(0, 1), b2 + hstep, voffB); PG8_STGA(PG8_SA(0, 0), a2, k2, 0, last);
            PG8_WAIT_V(8); PG8_WAIT_L(0); PG8_BAR; PG8_MMA(1, 0, At, B0); PG8_MMA(1, 1, At, B1); PG8_BAR; PG8_SCHED;
            PG8_LDB(B0, 1, 0); PG8_LDB(B1, 1, 1); PG8_SCHED; PG8_LDA(At, 1, 0); PG8_STGA(PG8_SA(0, 1), a2, k2, 1, last);
            PG8_WAIT_V(8); PG8_WAIT_L(0); PG8_BAR; PG8_MMA(0, 0, At, B0); PG8_MMA(0, 1, At, B1); PG8_BAR; PG8_SCHED;
            PG8_LDA(At, 1, 1); PG8_STAGE(PG8_SB(1, 0), b3, voffB); PG8_STAGE(PG8_SB(1, 1), b3 + hstep, voffB); PG8_STGA(PG8_SA(1, 0), a3, k3, 0, last);
            PG8_WAIT_V(8); PG8_WAIT_L(0); PG8_BAR; PG8_MMA(1, 0, At, B0); PG8_MMA(1, 1, At, B1); PG8_BAR; PG8_SCHED;
        }
        if (wr == 0) PG8_BAR;
        if constexpr (ES == 1) asm volatile("s_nop 15\n\ts_nop 7" ::: "memory");
        E(acc, cur, wr, wc, fr, fq);
        if (!has_next) break;
#pragma unroll
        for (int a = 0; a < 2; ++a)
#pragma unroll
            for (int b = 0; b < 2; ++b)
#pragma unroll
                for (int m = 0; m < 4; ++m)
#pragma unroll
                    for (int n = 0; n < 2; ++n) acc[a][b][m][n] = (f32x4){0.f, 0.f, 0.f, 0.f};
        cur = nxt; cA = nA; cB = nB; ++ui;
        if constexpr (GATHER) { _Pragma("unroll") for (int _i = 0; _i < 2; ++_i) { vA0[_i] = nA0[_i]; vA1[_i] = nA1[_i]; } }
        if (wr == 1) PG8_BAR;
    }
    PG8_WAIT_V(0);
    PG8_BAR;
#undef PG8_SA
#undef PG8_SB
#undef PG8_STAGE
#undef PG8_STGA
#undef PG8_ROWS
#undef PG8_LDA
#undef PG8_LDB
#undef PG8_MMA
#undef PG8_CAT8
#undef PG8_WAIT_V
#undef PG8_WAIT_L
#undef PG8_BAR
#undef PG8_SCHED
}
}

struct Args {
    const float* x; const int* positions; const float* norm1_g; const float* w_in;
    const float* lq1; const float* lk1; const float* lq2; const float* lk2;
    const float* diff_g; const float* ret_g; const float* w_o; const float* norm2_g;
    const float* w_router; const float* b_router; const float* w_moe_in; const float* b_moe_in;
    const float* w_moe_out; const float* b_moe_out; const float* norm_f_g;
    float* out; unsigned char* ws; int ph_lo, ph_hi;
};

#define KARGS const __attribute__((address_space(4))) Args&
typedef const __attribute__((address_space(4))) Args* KArgP;
__device__ __forceinline__ KArgP kargs() { KArgP p = (KArgP)__builtin_amdgcn_kernarg_segment_ptr(); asm volatile("" : "+s"(p)); return p; }
struct Frame {
    LAS unsigned char* lds;
    int tid, lane, wave, G, bid;
};

template <class RowMap>
__device__ __forceinline__ void transpose_item(const float* W, int K, int N, bf16_t* WT, LAS float* scr, int item, int lane, RowMap rowmap) {
    const int nblk = N / 32, kb = item / nblk, nb = item % nblk, k0 = 64 * kb, n0 = 32 * nb;
    float wv[32];
#pragma unroll
    for (int i = 0; i < 32; ++i) wv[i] = W[(size_t)(k0 + 2 * i + (lane >> 5)) * N + n0 + (lane & 31)];
#pragma unroll
    for (int i = 0; i < 32; ++i) scr[(2 * i + (lane >> 5)) * 33 + (lane & 31)] = wv[i];
    asm volatile("s_waitcnt lgkmcnt(0)" ::: "memory");
    const int c = lane & 7;
#pragma unroll
    for (int j = 0; j < 4; ++j) { const int n = (lane >> 3) + 8 * j; const LAS float* s = scr + (8 * c) * 33 + n;
        u32x4 o; o.x = pk2(s[0 * 33], s[1 * 33]); o.y = pk2(s[2 * 33], s[3 * 33]); o.z = pk2(s[4 * 33], s[5 * 33]); o.w = pk2(s[6 * 33], s[7 * 33]);
        *(u32x4*)(WT + (size_t)rowmap(n0 + n) * K + k0 + 8 * c) = o; }
    asm volatile("s_waitcnt lgkmcnt(0)" ::: "memory");
}
template <class RowMap>
__device__ __forceinline__ void transpose_item_fp8(const float* W, int K, int N, unsigned char* WT, LAS float* scr, int item, int lane, RowMap rowmap, float scale) {
    const int nblk = N / 32, kb = item / nblk, nb = item % nblk, k0 = 128 * kb, n0 = 32 * nb;
    { float wv[64];
#pragma unroll
      for (int i = 0; i < 64; ++i) wv[i] = __builtin_nontemporal_load(W + (size_t)(k0 + 2 * i + (lane >> 5)) * N + n0 + (lane & 31));
#pragma unroll
      for (int i = 0; i < 64; ++i) scr[(2 * i + (lane >> 5)) * 33 + (lane & 31)] = wv[i] * scale; }
    asm volatile("s_waitcnt lgkmcnt(0)" ::: "memory");
    const int c = lane & 7;
#pragma unroll
    for (int j = 0; j < 4; ++j) { const int n = (lane >> 3) + 8 * j; const LAS float* sp = scr + (16 * c) * 33 + n;
        u32x4 o; o.x = pk4_fp8(sp[0 * 33], sp[1 * 33], sp[2 * 33], sp[3 * 33]); o.y = pk4_fp8(sp[4 * 33], sp[5 * 33], sp[6 * 33], sp[7 * 33]);
        o.z = pk4_fp8(sp[8 * 33], sp[9 * 33], sp[10 * 33], sp[11 * 33]); o.w = pk4_fp8(sp[12 * 33], sp[13 * 33], sp[14 * 33], sp[15 * 33]);
        __builtin_nontemporal_store(o, (u32x4*)(WT + (size_t)rowmap(n0 + n) * K + k0 + 16 * c)); }
    asm volatile("s_waitcnt lgkmcnt(0)" ::: "memory");
}
__device__ __forceinline__ int win_rowmap(int n) {
    const bool isrope = (n < C_DV) || (n >= C_RQ && n < C_RV);
    if (!isrope) return n;
    const int d = n & 63, nn = d >> 5, i = d & 31;
    return (n & ~63) + 32 * (i >> 4) + 8 * ((i >> 2) & 3) + 4 * nn + (i & 3);
}
__device__ __forceinline__ int wmi_rowmap(int n) {
    const int t = n & 1, A = n >> 1;
    return 256 * (A >> 7) + 128 * t + (A & 127);
}
__device__ __forceinline__ int id_rowmap(int n) { return n; }

__device__ __forceinline__ void p0_prologue(const Frame& F, KARGS a, int parts = 7) {
    LAS float* scr = (LAS float*)(F.lds + F.wave * 16896);
    const int gw = F.bid * NWAVES + F.wave, NGW = F.G * NWAVES;
    bf16_t* Wt_in = (bf16_t*)(a.ws + WS_WIN); bf16_t* Wt_o = (bf16_t*)(a.ws + WS_WO); unsigned char* Wt_mi = a.ws + WS_WMI; unsigned char* Wt_mo = a.ws + WS_WMO;
    constexpr int I_IN = (DM / 64) * (PW / 32), I_O = (DM / 64) * (DM / 32), I_MI = (DM / 128) * (2 * FF / 32), I_MO = (FF / 128) * (DM / 32);
    constexpr int NITEMS = I_IN + I_O + NEXP * I_MI + NEXP * I_MO;
    if (parts & 1) for (int it = gw; it < NITEMS; it += NGW) {
        int r = it;
        if (r < I_IN) { transpose_item(a.w_in, DM, PW, Wt_in, scr, r, F.lane, win_rowmap); continue; } r -= I_IN;
        if (r < I_O) { transpose_item(a.w_o, DM, DM, Wt_o, scr, r, F.lane, id_rowmap); continue; } r -= I_O;
        if (r < NEXP * I_MI) { const int e = r / I_MI; transpose_item_fp8(a.w_moe_in + (size_t)e * DM * 2 * FF, DM, 2 * FF, Wt_mi + (size_t)e * 2 * FF * DM, scr, r % I_MI, F.lane, wmi_rowmap, W8_SCALE); continue; } r -= NEXP * I_MI;
        { const int e = r / I_MO; transpose_item_fp8(a.w_moe_out + (size_t)e * FF * DM, FF, DM, Wt_mo + (size_t)e * DM * FF, scr, r % I_MO, F.lane, id_rowmap, W8_SCALE); }
    }
    bf16_t* XN = (bf16_t*)(a.ws + WS_XN);
    if (parts & 2) { f32x4 g1[4];
#pragma unroll
      for (int j = 0; j < 4; ++j) g1[j] = *((const f32x4*)a.norm1_g + F.lane + 64 * j);
      for (int m0 = gw; m0 < NTOK; m0 += 2 * NGW) {
        const int m1 = (m0 + NGW < NTOK) ? m0 + NGW : m0;
        const f32x4* xa = (const f32x4*)(a.x + (size_t)m0 * DM) + F.lane; const f32x4* xb = (const f32x4*)(a.x + (size_t)m1 * DM) + F.lane;
        f32x4 va[4], vb[4]; float sa = 0.f, sb = 0.f;
#pragma unroll
        for (int j = 0; j < 4; ++j) { va[j] = __builtin_nontemporal_load(xa + 64 * j); vb[j] = __builtin_nontemporal_load(xb + 64 * j); }
#pragma unroll
        for (int j = 0; j < 4; ++j) { sa += (va[j].x * va[j].x + va[j].y * va[j].y) + (va[j].z * va[j].z + va[j].w * va[j].w); sb += (vb[j].x * vb[j].x + vb[j].y * vb[j].y) + (vb[j].z * vb[j].z + vb[j].w * vb[j].w); }
        const float ra = 1.0f / sqrtf(wave_sum(sa) * (1.0f / DM) + RMS_EPS), rb = 1.0f / sqrtf(wave_sum(sb) * (1.0f / DM) + RMS_EPS);
        unsigned long long* oa = (unsigned long long*)(XN + (size_t)m0 * DM) + F.lane; unsigned long long* ob = (unsigned long long*)(XN + (size_t)m1 * DM) + F.lane;
#pragma unroll
        for (int j = 0; j < 4; ++j) {
            oa[64 * j] = (unsigned long long)pk2(va[j].x * ra * g1[j].x, va[j].y * ra * g1[j].y) | ((unsigned long long)pk2(va[j].z * ra * g1[j].z, va[j].w * ra * g1[j].w) << 32);
            if (m1 != m0) ob[64 * j] = (unsigned long long)pk2(vb[j].x * rb * g1[j].x, vb[j].y * rb * g1[j].y) | ((unsigned long long)pk2(vb[j].z * rb * g1[j].z, vb[j].w * rb * g1[j].w) << 32); }
      } }
    float* rope = (float*)(a.ws + WS_ROPE);
    if (parts & 4) { const int i = F.lane & 31;
      const float inv_freq = 1.0f / powf(10000.0f, (float)(2 * i) / 64.0f);
      for (int m2 = gw; m2 < NTOK / 2; m2 += NGW) {
        const int row = 2 * m2 + (F.lane >> 5);
        const float ang = (float)a.positions[row] * inv_freq;
        const double q = (double)ang * 0.15915494309189535; const double r = ((double)ang - 6.283185307179586 * __builtin_rint(q));
        const float rf = (float)r;
        rope[(size_t)row * 64 + i] = __cosf(rf); rope[(size_t)row * 64 + 32 + i] = __sinf(rf);
      } }
}

__device__ __forceinline__ float ret_log2_gamma(int h) { return log2f(1.0f - exp2f(-5.0f - (float)h)); }
__device__ __forceinline__ void p2_ret_kv(const Frame& F, KARGS a) {
    const bf16_t* PROJ = (const bf16_t*)(a.ws + WS_PROJ); float* KVT = (float*)(a.ws + WS_KVT);
    LAS unsigned char* Kc = F.lds;
    LAS unsigned char* Vc = F.lds + 16384;
    const int lane = F.lane, w = F.wave, hi = lane >> 5;
    for (int u = F.bid; u < NB * 4 * NCH; u += F.G) {
        const int b = u / (4 * NCH), h = (u / NCH) & 3, n = u % NCH;
        const size_t row0 = (size_t)b * SEQ + (size_t)n * 128;
        const float lg = ret_log2_gamma(h);
        __syncthreads();
#pragma unroll
        for (int p = 0; p < 2; ++p) { const int idx = F.tid + p * NTHR, j = idx >> 3, c = idx & 7;
            u32x4 kv = *(const u32x4*)(PROJ + (row0 + j) * PW + C_RK + h * 64 + c * 8);
            const float dec = __builtin_amdgcn_exp2f(lg * (float)(127 - j));
            u32x4 o; o.x = pk2(bflo(kv.x) * dec, bfhi(kv.x) * dec); o.y = pk2(bflo(kv.y) * dec, bfhi(kv.y) * dec); o.z = pk2(bflo(kv.z) * dec, bfhi(kv.z) * dec); o.w = pk2(bflo(kv.w) * dec, bfhi(kv.w) * dec);
            *(LAS u32x4*)(Kc + j * 128 + c * 16) = o; }
#pragma unroll
        for (int p = 0; p < 4; ++p) { const int idx = F.tid + p * NTHR, j = idx >> 4, c = idx & 15;
            *(LAS u32x4*)(Vc + j * 256 + c * 16) = *(const u32x4*)(PROJ + (row0 + j) * PW + C_RV + h * 128 + c * 8); }
        __syncthreads();
        const int eb = w >> 1, db = w & 1;
        f32x16 acc = {};
        const int rsub = (lane & 15) >> 2, cb = 16 * ((lane >> 4) & 1) + 4 * (lane & 3);
#pragma unroll
        for (int s = 0; s < 8; ++s) {
            const int jlo = 16 * s + 4 * hi + rsub, jhi = jlo + 8;
            const bf16x8 af = cat8(tr_read(Vc + jlo * 256 + (32 * eb + cb) * 2), tr_read(Vc + jhi * 256 + (32 * eb + cb) * 2));
            const bf16x8 bfr = cat8(tr_read(Kc + jlo * 128 + (32 * db + cb) * 2), tr_read(Kc + jhi * 128 + (32 * db + cb) * 2));
            acc = MFMA32(af, bfr, acc);
        }
        float* o = KVT + (size_t)u * 8192;
#pragma unroll
        for (int r = 0; r < 16; ++r) o[(32 * eb + crow(r, hi)) * 64 + 32 * db + (lane & 31)] = acc[r];
    }
}
__device__ __forceinline__ void p3_ret_scan(const Frame& F, KARGS a) {
    const float* __restrict__ KVT = (const float*)(a.ws + WS_KVT); bf16_t* __restrict__ PREVT = (bf16_t*)(a.ws + WS_PREVT);
    for (int g = F.bid * NTHR + F.tid; g < NB * 4 * 8192; g += F.G * NTHR) {
        const int bh = g >> 13, ed = g & 8191, h = bh & 3;
        const float cd = exp2f(ret_log2_gamma(h) * 128.0f);
        float st = 0.f;
        for (int n0 = 0; n0 < NCH; n0 += 16) {
            float kv[16];
#pragma unroll
            for (int q = 0; q < 16; ++q) kv[q] = KVT[((size_t)(bh * NCH + n0 + q) << 13) + ed];
#pragma unroll
            for (int q = 0; q < 16; ++q) { PREVT[((size_t)(bh * NCH + n0 + q) << 13) + ed] = (bf16_t)f2bf(st); st = st * cd + kv[q]; }
        }
    }
}

__device__ __forceinline__ unsigned cvtpk(float lo, float hi) { typedef __bf16 bf16x2_t __attribute__((ext_vector_type(2))); f32x2 v = {lo, hi}; bf16x2_t b = __builtin_convertvector(v, bf16x2_t); return __builtin_bit_cast(unsigned, b); }
__device__ __forceinline__ bf16x8 packp(const f32x16& p, int b) {
    u32x4 w; w.x = cvtpk(p[b], p[b + 1]); w.y = cvtpk(p[b + 2], p[b + 3]); w.z = cvtpk(p[b + 4], p[b + 5]); w.w = cvtpk(p[b + 6], p[b + 7]);
    return __builtin_bit_cast(bf16x8, w);
}
__device__ __forceinline__ float halfmax(float m) { auto rr = __builtin_amdgcn_permlane32_swap(__float_as_uint(m), __float_as_uint(m), false, false); return fmaxf(__uint_as_float(rr[0]), __uint_as_float(rr[1])); }
__device__ __forceinline__ float halfsum(float m) { auto rr = __builtin_amdgcn_permlane32_swap(__float_as_uint(m), __float_as_uint(m), false, false); return __uint_as_float(rr[0]) + __uint_as_float(rr[1]); }
__device__ __forceinline__ void glds16(const void* gsrc, unsigned lds_dst) { unsigned keep;
    asm volatile("s_mov_b32 %0, m0\n\ts_mov_b32 m0, %2\n\ts_nop 0\n\tglobal_load_lds_dwordx4 %1, off\n\ts_mov_b32 m0, %0" : "=&s"(keep) : "v"(gsrc), "s"(lds_dst) : "memory"); }
__device__ __forceinline__ float max3f(float a, float b, float c) { return fmaxf(fmaxf(a, b), c); }
__device__ __forceinline__ float fadd_s(float a, float b) { return a + b; }
constexpr float ATT_THR = 8.0f;
__device__ __forceinline__ void attn_unit(const Frame& F, KARGS a, int b, int h, int qb, float lam) {
    const bf16_t* PROJ = (const bf16_t*)(a.ws + WS_PROJ); bf16_t* MIX = (bf16_t*)(a.ws + WS_MIX);
    const int lane = F.lane, w = F.wave, hi = lane >> 5, r32 = lane & 31, br = w >> 2, ib = w & 3;
    const size_t rowb = (size_t)b * SEQ;
    const int q0 = qb * 128 + ib * 32;
    const int NT = 2 * qb + 2;
    const int ntw = 2 * qb + (ib >= 2 ? 2 : 1);
    LAS unsigned char* qfl = F.lds + 114688 + w * 4096 + lane * 16;
    __syncthreads();
    { const bf16_t* qp = PROJ + (rowb + q0 + r32) * PW + C_DQ + h * 128 + br * 64 + hi * 8;
#pragma unroll
      for (int d0 = 0; d0 < 4; ++d0) *(LAS bf16x8*)(qfl + d0 * 1024) = *(const bf16x8*)(qp + d0 * 16); }
    f32x16 o[4]; o[0] = f32x16{}; o[1] = f32x16{}; o[2] = f32x16{}; o[3] = f32x16{};
    float mrun = 0.f, lrun = 0.f;
    bool refzero = true;
    const bf16_t* kg0 = PROJ + (rowb + (w & 3) * 16 + (lane >> 2)) * PW + C_DK + h * 128 + ((w >> 2) * 4 + ((lane & 3) ^ ((lane >> 4) & 3))) * 8;
    const bf16_t* vg0 = PROJ + (rowb + (w & 3) * 16 + (lane >> 2)) * PW + C_DV + h * 128 + (w >> 2) * 32 + (lane & 3) * 8;
    const unsigned lds0 = (unsigned)(uintptr_t)F.lds + (unsigned)w * 1024u;
#define AT_STAGE_K(t, ks) do { const size_t ro_ = (size_t)((t) < NT ? (t) : NT - 1) * 64 * PW; const unsigned sb_ = (unsigned)__builtin_amdgcn_readfirstlane((int)(lds0 + (unsigned)(ks) * 16384u)); \
        glds16(kg0 + ro_, sb_); glds16(kg0 + ro_ + 64, sb_ + 8192u); } while (0)
#define AT_STAGE_V(t, vs) do { const size_t ro_ = (size_t)((t) < NT ? (t) : NT - 1) * 64 * PW; const unsigned sb_ = (unsigned)__builtin_amdgcn_readfirstlane((int)(lds0 + 49152u + (unsigned)(vs) * 16384u)); \
        glds16(vg0 + ro_, sb_); glds16(vg0 + ro_ + 64, sb_ + 8192u); } while (0)
#define AT_KOFF(d0) ((((2 * br + ((d0) >> 1)) * 4 + (r32 >> 4)) * 1024) + ((r32 & 15) * 4 + ((2 * ((d0) & 1) + hi) ^ ((r32 >> 2) & 3))) * 16)
#define AT_QK_BODY(dst0, dst1, ks, cinit) do { const LAS unsigned char* kp_ = F.lds + (ks) * 16384; \
        bf16x8 ka_ = *(const LAS bf16x8*)(kp_ + AT_KOFF(0)), kb_ = *(const LAS bf16x8*)(kp_ + AT_KOFF(0) + 2048), qa_ = *(const LAS bf16x8*)(qfl); \
        __builtin_amdgcn_s_setprio(1); \
        _Pragma("unroll") for (int d0 = 0; d0 < 4; ++d0) { bf16x8 kc_ = ka_, kd_ = kb_, qc_ = qa_; \
            if (d0 < 3) { ka_ = *(const LAS bf16x8*)(kp_ + AT_KOFF(d0 + 1)); kb_ = *(const LAS bf16x8*)(kp_ + AT_KOFF(d0 + 1) + 2048); qa_ = *(const LAS bf16x8*)(qfl + (d0 + 1) * 1024); } \
            if (d0 == 0) { dst0 = MFMA32(kc_, qc_, cinit); dst1 = MFMA32(kd_, qc_, cinit); } else { dst0 = MFMA32(kc_, qc_, dst0); dst1 = MFMA32(kd_, qc_, dst1); } } \
        __builtin_amdgcn_s_setprio(0); } while (0)
#define AT_QK(dst0, dst1, ks) do { if (refzero) { const f32x16 z_ = f32x16{}; AT_QK_BODY(dst0, dst1, ks, z_); } \
        else { f32x16 nm_; _Pragma("unroll") for (int r = 0; r < 16; ++r) nm_[r] = -mrun; AT_QK_BODY(dst0, dst1, ks, nm_); } } while (0)
#define AT_BAR(n) do { asm volatile("s_waitcnt vmcnt(" #n ") lgkmcnt(0)" ::: "memory"); __builtin_amdgcn_s_barrier(); asm volatile("" ::: "memory"); } while (0)
#define AT_SOFTMAX(C0, C1, N0, N1, t, PF) do { \
        if ((t) == ntw - 1) { const int qi = q0 + r32 - (t) * 64; \
            _Pragma("unroll") for (int r = 0; r < 16; ++r) { const int kv = crow(r, hi); if (kv > qi) C0[r] = -INFINITY; if (kv + 32 > qi) C1[r] = -INFINITY; } } \
        float mx; { float a_ = max3f(C0[0], C0[1], C1[0]), b_ = max3f(C0[2], C0[3], C1[1]); a_ = max3f(a_, C1[2], C1[3]); \
            _Pragma("unroll") for (int r = 4; r < 16; r += 4) { a_ = max3f(a_, C0[r], C0[r + 1]); b_ = max3f(b_, C0[r + 2], C0[r + 3]); a_ = max3f(a_, C1[r], C1[r + 1]); b_ = max3f(b_, C1[r + 2], C1[r + 3]); } \
            mx = halfmax(fmaxf(a_, b_)); } \
          \
        if (__any(mx > ATT_THR) || ((t) == 0 && __any(mx < -ATT_THR))) { \
            const float dl = ((t) == 0) ? mx : fmaxf(mx, 0.f); mrun += dl; const float f = __builtin_amdgcn_exp2f(-dl); lrun *= f; refzero = false; \
            _Pragma("unroll") for (int d = 0; d < 4; ++d) _Pragma("unroll") for (int r = 0; r < 16; ++r) o[d][r] *= f; \
            _Pragma("unroll") for (int r = 0; r < 16; ++r) { C0[r] -= dl; C1[r] -= dl; N0[r] -= dl; N1[r] -= dl; } } \
        _Pragma("unroll") for (int r = 0; r < 16; ++r) { C0[r] = __builtin_amdgcn_exp2f(C0[r]); C1[r] = __builtin_amdgcn_exp2f(C1[r]); } \
          \
        _Pragma("unroll") for (int r = 0; r < 16; ++r) lrun += C0[r]; \
        _Pragma("unroll") for (int r = 0; r < 16; ++r) lrun += C1[r]; \
        PF[0] = packp(C0, 0); PF[1] = packp(C0, 8); PF[2] = packp(C1, 0); PF[3] = packp(C1, 8); } while (0)
#define AT_PV(vs, PF) do { \
        const LAS unsigned char* vp = F.lds + 49152 + (vs) * 16384 + ((lane >> 4) & 1) * 32 + (lane & 3) * 8 + (4 * hi + ((lane & 15) >> 2)) * 64; \
        bf16x8 vr_[2]; \
        vr_[0] = cat8(tr_read(vp), tr_read(vp + 512)); \
        __builtin_amdgcn_s_setprio(1); \
        _Pragma("unroll") for (int i = 0; i < 16; ++i) { \
            if (i + 1 < 16) vr_[(i + 1) & 1] = cat8(tr_read(vp + ((i + 1) & 3) * 4096 + ((i + 1) >> 2) * 1024), tr_read(vp + ((i + 1) & 3) * 4096 + ((i + 1) >> 2) * 1024 + 512)); \
            o[i & 3] = MFMA32(vr_[i & 1], PF[i >> 2], o[i & 3]); } \
        __builtin_amdgcn_s_setprio(0); } while (0)
    AT_STAGE_K(0, 0); AT_STAGE_V(0, 0); AT_STAGE_K(1, 1);
    AT_STAGE_K(2, 2); AT_STAGE_V(1, 1);
    AT_BAR(4);
    f32x16 cA0, cA1, cB0, cB1;
    AT_QK(cA0, cA1, 0);
    bf16x8 pfb[4];
    int kcur = 0;
#define AT_STEP(C0, C1, N0, N1, t) do { \
        { const int kst = kcur; AT_STAGE_K((t) + 3, kst); AT_STAGE_V((t) + 2, ((t) + 2) & 3); }        \
        const int ksn_ = kcur == 2 ? 0 : kcur + 1;                                                     \
          \
        if (br == 1 && (t) >= 1 && (t) - 1 < ntw) AT_PV(((t) - 1) & 3, pfb); \
        if ((t) < ntw) { if ((t) + 1 < ntw) AT_QK(N0, N1, ksn_); AT_SOFTMAX(C0, C1, N0, N1, t, pfb); } \
        if (br == 0 && (t) < ntw) AT_PV((t) & 3, pfb); \
        AT_BAR(4); \
        kcur = ksn_; } while (0)
    for (int t = 0; t < NT; t += 2) {
        AT_STEP(cA0, cA1, cB0, cB1, t);
        AT_STEP(cB0, cB1, cA0, cA1, t + 1);
    }
    if (br == 1 && ntw == NT) AT_PV((NT - 1) & 3, pfb);
#undef AT_STEP
#undef AT_SOFTMAX
#undef AT_PV
    asm volatile("s_waitcnt vmcnt(0) lgkmcnt(0)" ::: "memory");
    __syncthreads();
#undef AT_STAGE_K
#undef AT_STAGE_V
#undef AT_QK
#undef AT_QK_BODY
#undef AT_KOFF
#undef AT_BAR
    lrun = halfsum(lrun);
    const float il = 1.0f / lrun;
    LAS float* cmb = (LAS float*)F.lds + ib * 4096;
    if (br == 1) {
#pragma unroll
        for (int d = 0; d < 4; ++d)
#pragma unroll
            for (int r = 0; r < 16; ++r) cmb[(32 * d + crow(r, hi)) * 32 + r32] = o[d][r] * il;
    }
    __syncthreads();
    if (br == 0) {
        float ss = 0.f;
#pragma unroll
        for (int d = 0; d < 4; ++d)
#pragma unroll
            for (int r = 0; r < 16; ++r) { const float v = o[d][r] * il - lam * cmb[(32 * d + crow(r, hi)) * 32 + r32]; o[d][r] = v; ss += v * v; }
        ss = halfsum(ss);
        const float rn = 0.8f / sqrtf(ss * (1.0f / 128.0f) + RMS_EPS);
        LAS bf16_t* stg = (LAS bf16_t*)(F.lds + 65536) + ib * 4096;
#pragma unroll
        for (int d = 0; d < 4; ++d)
#pragma unroll
            for (int r = 0; r < 16; ++r) { const int dv = 32 * d + crow(r, hi); stg[r32 * 128 + dv] = (bf16_t)f2bf(o[d][r] * rn * a.diff_g[dv]); }
        asm volatile("s_waitcnt lgkmcnt(0)" ::: "memory");
#pragma unroll
        for (int i = 0; i < 8; ++i) { const int row = i * 4 + (lane >> 4), ch = lane & 15;
            *(u32x4*)(MIX + (rowb + q0 + row) * DM + h * 128 + ch * 8) = *(const LAS u32x4*)(stg + row * 128 + ch * 8); }
    }
}
__device__ __forceinline__ void ret_unit(const Frame& F, KARGS a, int item0) {
    const bf16_t* PROJ = (const bf16_t*)(a.ws + WS_PROJ); bf16_t* MIX = (bf16_t*)(a.ws + WS_MIX); const bf16_t* PREVT = (const bf16_t*)(a.ws + WS_PREVT);
    const int lane = F.lane, w = F.wave, hi = lane >> 5, r32 = lane & 31, q4 = w >> 2, ib = w & 3;
    const int item = item0 + q4;
    const int b = item / (4 * NCH), h = (item / NCH) & 3, n = item % NCH;
    const size_t row0 = (size_t)b * SEQ + (size_t)n * 128;
    const float lg = ret_log2_gamma(h);
    LAS unsigned char* Kb = F.lds + q4 * 49152;
    LAS unsigned char* Vb = Kb + 16384;
    const int t4 = F.tid & 255;
    __syncthreads();
#pragma unroll
    for (int p = 0; p < 4; ++p) { const int idx = t4 + p * 256, c = idx >> 7, key = idx & 127;
        *(LAS u32x4*)(Kb + idx * 16) = *(const u32x4*)(PROJ + (row0 + key) * PW + C_RK + h * 64 + c * 8); }
#pragma unroll
    for (int p = 0; p < 8; ++p) { const int idx = t4 + p * 256, j = idx >> 4, c = idx & 15;
        *(LAS u32x4*)(Vb + j * 256 + c * 16) = *(const u32x4*)(PROJ + (row0 + j) * PW + C_RV + h * 128 + c * 8); }
    bf16x8 qf[4];
    { const bf16_t* qp = PROJ + (row0 + ib * 32 + r32) * PW + C_RQ + h * 64 + hi * 8;
#pragma unroll
      for (int d0 = 0; d0 < 4; ++d0) qf[d0] = *(const bf16x8*)(qp + d0 * 16); }
    f32x16 acc[4];
    { const bf16_t* pp = PREVT + (size_t)item * 8192 + (size_t)r32 * 64 + hi * 8;
#pragma unroll
      for (int eb = 0; eb < 4; ++eb) { acc[eb] = f32x16{};
#pragma unroll
          for (int s = 0; s < 4; ++s) { const bf16x8 af = *(const bf16x8*)(pp + eb * 32 * 64 + s * 16); acc[eb] = MFMA32(af, qf[s], acc[eb]); } } }
    const int i = ib * 32 + r32;
    { const float qd = exp2f(lg * (float)(i + 1));
#pragma unroll
      for (int eb = 0; eb < 4; ++eb)
#pragma unroll
          for (int r = 0; r < 16; ++r) acc[eb][r] *= qd; }
    __syncthreads();
    const int rsub = (lane & 15) >> 2, cb = 16 * ((lane >> 4) & 1) + 4 * (lane & 3);
    for (int jb = 0; jb <= ib; ++jb) {
        f32x16 s0 = {};
        const LAS unsigned char* kp = Kb + hi * 2048 + (jb * 32 + r32) * 16;
#pragma unroll
        for (int d0 = 0; d0 < 4; ++d0) { const bf16x8 kf = *(const LAS bf16x8*)(kp + d0 * 4096); s0 = MFMA32(kf, qf[d0], s0); }
#pragma unroll
        for (int r = 0; r < 16; ++r) { const int j = jb * 32 + crow(r, hi); s0[r] = (i >= j) ? s0[r] * exp2f(lg * (float)(i - j)) : 0.f; }
        bf16x8 pf[2]; pf[0] = pack8(s0, 0); pf[1] = pack8(s0, 8);
#pragma unroll
        for (int eb = 0; eb < 4; ++eb)
#pragma unroll
            for (int s = 0; s < 2; ++s) {
                const int jlo = jb * 32 + 16 * s + 4 * hi + rsub, jhi = jlo + 8;
                const bf16x8 vf = cat8(tr_read(Vb + jlo * 256 + (32 * eb + cb) * 2), tr_read(Vb + jhi * 256 + (32 * eb + cb) * 2));
                acc[eb] = MFMA32(vf, pf[s], acc[eb]);
            }
    }
    float ss = 0.f;
#pragma unroll
    for (int eb = 0; eb < 4; ++eb)
#pragma unroll
        for (int r = 0; r < 16; ++r) ss += acc[eb][r] * acc[eb][r];
    ss += __shfl_xor(ss, 32);
    const float rn = 1.0f / sqrtf(ss * (1.0f / 128.0f) + RMS_EPS);
    const bf16_t* gp = PROJ + (row0 + i) * PW + C_RG + h * 128;
    bf16_t* op = MIX + (row0 + i) * DM + 512 + h * 128;
#pragma unroll
    for (int eb = 0; eb < 4; ++eb)
#pragma unroll
        for (int r = 0; r < 16; ++r) { const int e = 32 * eb + crow(r, hi);
            const float g = bf2f(gp[e]); const float sg = g / (1.0f + exp2f(-LOG2E * g));
            op[e] = (bf16_t)f2bf(acc[eb][r] * rn * a.ret_g[h * 128 + e] * sg); }
}
__device__ __forceinline__ void p4_mixers(const Frame& F, KARGS a) {
    float lam;
    { const float p1 = a.lq1[F.lane] * a.lk1[F.lane], p2 = a.lq2[F.lane] * a.lk2[F.lane];
      lam = expf(wave_sum(p1)) - expf(wave_sum(p2)) + 0.2f; }
    const int NU = NB * 4 * 64;
    for (int L0 = F.bid, round0 = 0; L0 < NU * (((DOUBLE_MASK >> 4) & 1) + 1); L0 += F.G, ++round0) {
        const int L = L0 >= NU ? L0 - NU : L0, round = round0 & 3;
        int rank = L >> 4; const int bh = L & 15;
        int qb = 63 - rank;
        if (F.G == 256 && (round & 1)) { const int lo = (round * 256) >> 4, hi_ = lo + 15; qb = 63 - (lo + hi_ - rank); }
        attn_unit(F, a, bh >> 2, bh & 3, qb, lam);
    }
    for (int u0 = F.bid; u0 < (NB * 4 * NCH / 2) * (((DOUBLE_MASK >> 11) & 1) + 1); u0 += F.G) ret_unit(F, a, 2 * (u0 >= (NB * 4 * NCH / 2) ? u0 - (NB * 4 * NCH / 2) : u0));
}

constexpr int WR_ROWB = 2080;
constexpr int LDS_WRL = 32 * WR_ROWB;
constexpr int LDS_LCNT = 2 * 32 * WR_ROWB;
constexpr int LDS_LGS = LDS_LCNT + 256;
constexpr int LDS_TOP = LDS_LGS + 8 * 2048;
__device__ __forceinline__ void p6_router(const Frame& F, KARGS a) {
    const bf16_t* X1 = (const bf16_t*)(a.ws + WS_X1B); unsigned* TK = (unsigned*)(a.ws + WS_TOPK);
    const int lane = F.lane;
    for (int idx = F.tid; idx < DM * NEXP; idx += NTHR) { const int k = idx >> 5, e = idx & 31;
        const float v = a.w_router[idx] * a.norm2_g[k]; const unsigned h = f2bf(v); const float hf = __builtin_bit_cast(float, h << 16);
        *(LAS bf16_t*)(F.lds + e * WR_ROWB + k * 2) = (bf16_t)h; *(LAS bf16_t*)(F.lds + LDS_WRL + e * WR_ROWB + k * 2) = (bf16_t)f2bf(v - hf); }
    LAS unsigned* lcnt = (LAS unsigned*)(F.lds + LDS_LCNT);
    if (F.tid < 32) lcnt[F.tid] = 0u;
    __syncthreads();
    const int t16 = lane & 15, kb = lane >> 4;
    LAS float* lgs = (LAS float*)(F.lds + LDS_LGS) + F.wave * 512;
    LAS float* tops = (LAS float*)(F.lds + LDS_TOP) + F.wave * 64;
    const int RPW = (NTOK + F.G - 1) / F.G;
    for (int rb = F.wave * 16; rb < RPW; rb += NWAVES * 16) {
        const int m0 = F.bid * RPW + rb;
        if (m0 >= NTOK) break;
        const int mrow = (m0 + t16 < NTOK && rb + t16 < RPW) ? m0 + t16 : m0;
        const bf16_t* xr = X1 + (size_t)mrow * DM + 8 * kb;
        f32x4 acc0 = {0.f, 0.f, 0.f, 0.f}, acc1 = {0.f, 0.f, 0.f, 0.f}; float ss = 0.f;
        const LAS unsigned char* wp = F.lds + t16 * WR_ROWB + kb * 16;
#pragma unroll 4
        for (int s = 0; s < 32; ++s) {
            const u32x4 xw = *(const u32x4*)(xr + 32 * s);
            { const float a0 = bflo(xw.x), a1 = bfhi(xw.x), a2 = bflo(xw.y), a3 = bfhi(xw.y), a4 = bflo(xw.z), a5 = bfhi(xw.z), a6 = bflo(xw.w), a7 = bfhi(xw.w);
              ss += (a0 * a0 + a1 * a1) + (a2 * a2 + a3 * a3) + (a4 * a4 + a5 * a5) + (a6 * a6 + a7 * a7); }
            const bf16x8 xh = __builtin_bit_cast(bf16x8, xw);
            const bf16x8 wh0 = *(const LAS bf16x8*)(wp + s * 64), wl0 = *(const LAS bf16x8*)(wp + LDS_WRL + s * 64);
            const bf16x8 wh1 = *(const LAS bf16x8*)(wp + 16 * WR_ROWB + s * 64), wl1 = *(const LAS bf16x8*)(wp + LDS_WRL + 16 * WR_ROWB + s * 64);
            acc0 = __builtin_amdgcn_mfma_f32_16x16x32_bf16(wh0, xh, acc0, 0, 0, 0); acc1 = __builtin_amdgcn_mfma_f32_16x16x32_bf16(wh1, xh, acc1, 0, 0, 0);
            acc0 = __builtin_amdgcn_mfma_f32_16x16x32_bf16(wl0, xh, acc0, 0, 0, 0); acc1 = __builtin_amdgcn_mfma_f32_16x16x32_bf16(wl1, xh, acc1, 0, 0, 0);
        }
        ss += __shfl_xor(ss, 16); ss += __shfl_xor(ss, 32);
        const float r2 = 1.0f / sqrtf(ss * (1.0f / DM) + RMS_EPS);
        float val[8];
        { const f32x4 b0 = *(const f32x4*)(a.b_router + 4 * kb), b1 = *(const f32x4*)(a.b_router + 16 + 4 * kb);
#pragma unroll
          for (int jx = 0; jx < 4; ++jx) { val[jx] = acc0[jx] * r2 + b0[jx]; val[4 + jx] = acc1[jx] * r2 + b1[jx]; } }
        *(LAS f32x4*)(lgs + t16 * 32 + 4 * kb) = (f32x4){val[0], val[1], val[2], val[3]};
        *(LAS f32x4*)(lgs + t16 * 32 + 16 + 4 * kb) = (f32x4){val[4], val[5], val[6], val[7]};
        asm volatile("s_waitcnt lgkmcnt(0)" ::: "memory");
        int rank[8];
#pragma unroll
        for (int i = 0; i < 8; ++i) rank[i] = 0;
#pragma unroll
        for (int e4 = 0; e4 < 8; ++e4) { const f32x4 o = *(const LAS f32x4*)(lgs + t16 * 32 + 4 * e4);
#pragma unroll
            for (int c = 0; c < 4; ++c) { const int oe = 4 * e4 + c;
#pragma unroll
                for (int i = 0; i < 8; ++i) { const int me = 16 * (i >> 2) + 4 * kb + (i & 3); rank[i] += (o[c] > val[i] || (o[c] == val[i] && oe < me)) ? 1 : 0; } } }
#pragma unroll
        for (int i = 0; i < 8; ++i) if (rank[i] < 4) tops[t16 * 4 + rank[i]] = val[i];
        asm volatile("s_waitcnt lgkmcnt(0)" ::: "memory");
        const f32x4 tv = *(const LAS f32x4*)(tops + t16 * 4);
        const float e1 = expf(tv[1] - tv[0]), e2 = expf(tv[2] - tv[0]), e3 = expf(tv[3] - tv[0]);
        const float inv = 1.0f / (1.0f + e1 + e2 + e3);
        const bool rowok = (m0 + t16 < NTOK) && (rb + t16 < RPW);
        if (rowok) { unsigned* trow = TK + (size_t)(m0 + t16) * 16;
#pragma unroll
            for (int i = 0; i < 8; ++i) if (rank[i] < 4) { const int me = 16 * (i >> 2) + 4 * kb + (i & 3); const int rk = rank[i];
                const float gt = (rk == 0 ? 1.0f : rk == 1 ? e1 : rk == 2 ? e2 : e3) * inv;
                const unsigned slot = __hip_atomic_fetch_add(lcnt + me, 1u, __ATOMIC_RELAXED, __HIP_MEMORY_SCOPE_WORKGROUP);
                trow[rk] = (unsigned)me; trow[4 + rk] = __builtin_bit_cast(unsigned, gt); trow[8 + rk] = slot; }
            if (kb == 0) trow[12] = __builtin_bit_cast(unsigned, r2); }
        for (int i = 0; i < 16; ++i) { const int m = m0 + i; if (m >= NTOK || rb + i >= RPW) break;
            const float r2i = __shfl(r2, i);
            const u32x2* x4 = (const u32x2*)(X1 + (size_t)m * DM) + lane; unsigned* h2 = (unsigned*)(a.ws + WS_H2 + (size_t)m * DM) + lane;
#pragma unroll
            for (int jx = 0; jx < 4; ++jx) { const u32x2 v = x4[64 * jx]; const f32x4 g = *((const f32x4*)a.norm2_g + lane + 64 * jx);
                h2[64 * jx] = pk4_fp8(bflo(v.x) * r2i * g.x, bfhi(v.x) * r2i * g.y, bflo(v.y) * r2i * g.z, bfhi(v.y) * r2i * g.w); } }
    }
    __syncthreads();
    { int t2 = threadIdx.x; asm volatile("" : "+v"(t2));
      if (t2 < 32) ((unsigned*)(a.ws + WS_HIST))[F.bid * 32 + t2] = lcnt[t2]; }
}
__device__ __forceinline__ unsigned expert_offsets(const unsigned* ctl, int lane, unsigned& ntiles) {
    const unsigned c = (lane < 32) ? __hip_atomic_load(ctl + CW_CNT + (lane & 31), __ATOMIC_RELAXED, __HIP_MEMORY_SCOPE_AGENT) : 0u;
    const unsigned t = (c + 255u) >> 8;
    unsigned inc = t;
#pragma unroll
    for (int o = 1; o < 32; o <<= 1) { const unsigned v = __shfl_up(inc, o); if ((lane & 31) >= o) inc += v; }
    ntiles = __shfl(inc, 31);
    return (inc - t) << 8;
}
__device__ __forceinline__ void p7_scatter(const Frame& F, KARGS a) {
    unsigned* TK = (unsigned*)(a.ws + WS_TOPK); unsigned* RL = (unsigned*)(a.ws + WS_ROWLIST);
    const int lane = F.lane;
    LAS unsigned* red = (LAS unsigned*)(F.lds);
    { const unsigned* hist = (const unsigned*)(a.ws + WS_HIST);
      const int e = F.tid & 31, part = F.tid >> 5, per = (F.G + 15) / 16;
      unsigned sa = 0, sb = 0;
      for (int wg = part * per; wg < (part + 1) * per && wg < F.G; ++wg) { const unsigned c = hist[wg * 32 + e]; sa += c; if (wg < F.bid) sb += c; }
      red[part * 32 + e] = sa; red[512 + part * 32 + e] = sb; }
    __syncthreads();
    if (F.tid < 64) {
        unsigned tot = 0, base = 0;
        if (lane < 32) for (int p = 0; p < 16; ++p) { tot += red[p * 32 + lane]; base += red[512 + p * 32 + lane]; }
        const unsigned tl = (tot + 255u) >> 8; unsigned inc = tl;
#pragma unroll
        for (int o = 1; o < 32; o <<= 1) { const unsigned v = __shfl_up(inc, o); if ((lane & 31) >= o) inc += v; }
        if (lane < 32) { red[1024 + lane] = ((inc - tl) << 8) + base; red[1056 + lane] = (inc - tl) << 8; red[1088 + lane] = tot; if (F.bid == 0) ((unsigned*)(a.ws + WS_CTL))[CW_CNT + lane] = tot; }
    }
    __syncthreads();
    if (F.bid < NEXP) { const unsigned st = red[1056 + F.bid] + red[1088 + F.bid], en = red[1056 + F.bid] + (((red[1088 + F.bid] + 255u) >> 8) << 8);
        for (unsigned p = st + F.tid; p < en; p += NTHR) RL[p] = 0u; }
    const unsigned myoff = red[1024 + (lane & 31)];
    const int RPW = (NTOK + F.G - 1) / F.G, RPV = (RPW + NWAVES - 1) / NWAVES;
    for (int i = 0; i < RPV; ++i) {
        const int ml = F.wave * RPV + i, m = F.bid * RPW + ml;
        if (ml >= RPW || m >= NTOK) break;
        unsigned* t = TK + (size_t)m * 16;
        unsigned e = 0, sl = 0;
        if (lane < 4) { e = t[lane]; sl = t[8 + lane]; }
        const unsigned pos = __shfl(myoff, (int)e) + sl;
        if (lane < 4) { RL[pos] = (unsigned)m; t[8 + lane] = pos; }
    }
}
__device__ __forceinline__ int build_tile_table(const Frame& F, KARGS a) {
    const unsigned* ctl = (const unsigned*)(a.ws + WS_CTL);
    unsigned ntiles; const unsigned myoff = expert_offsets(ctl, F.lane, ntiles);
    LAS unsigned char* tab = F.lds + LDS_MISC;
    const unsigned nextoff = __shfl_down(myoff, 1);
    __syncthreads();
    if (F.wave == 0 && F.lane < 32) {
        const unsigned t0 = myoff >> 8, t1 = (F.lane == 31) ? ntiles : (nextoff >> 8);
        for (unsigned t = t0; t < t1; ++t) tab[t] = (unsigned char)F.lane;
    }
    __syncthreads();
    return __builtin_amdgcn_readfirstlane((int)ntiles);
}
template <class Sched>
__device__ __forceinline__ void build_row_table(const Frame& F, KARGS a, const Sched& S) {
    const unsigned* RL = (const unsigned*)(a.ws + WS_ROWLIST);
    LAS unsigned* rtab = (LAS unsigned*)(F.lds + LDS_ROWTAB);
    pg8::Unit u;
    for (int ui = 0; ui < ROWTAB_UNITS && S.next(ui, u); ++ui)
        if (F.tid < 256) rtab[ui * 256 + F.tid] = RL[(size_t)u.pm * 256 + F.tid] << 10;
    __syncthreads();
}
__device__ __forceinline__ void p10_final(const Frame& F, KARGS a) {
    const bf16_t* X1 = (const bf16_t*)(a.ws + WS_X1B); float* OUT = a.out; const unsigned* TK = (const unsigned*)(a.ws + WS_TOPK); const unsigned char* Y = a.ws + WS_Y;
    const int gw = F.bid * NWAVES + F.wave, NGW = F.G * NWAVES, lane = F.lane;
    f32x4 gf[4];
#pragma unroll
    for (int j = 0; j < 4; ++j) gf[j] = *((const f32x4*)a.norm_f_g + lane + 64 * j);
    for (int m0 = gw; m0 < NTOK; m0 += 2 * NGW) {
        const int m1 = m0 + NGW; const bool two = m1 < NTOK; const int mb = two ? m1 : m0;
        const unsigned* t0 = TK + (size_t)m0 * 16; const unsigned* t1 = TK + (size_t)mb * 16;
        float g0[4], g1[4]; unsigned p0[4], p1[4];
#pragma unroll
        for (int k = 0; k < 4; ++k) { g0[k] = __builtin_bit_cast(float, t0[4 + k]); p0[k] = t0[8 + k]; g1[k] = __builtin_bit_cast(float, t1[4 + k]); p1[k] = t1[8 + k]; }
        const u32x2* x0 = (const u32x2*)(X1 + (size_t)m0 * DM) + lane; const u32x2* x1 = (const u32x2*)(X1 + (size_t)mb * DM) + lane;
        f32x4* q0 = (f32x4*)(OUT + (size_t)m0 * DM) + lane; f32x4* q1 = (f32x4*)(OUT + (size_t)mb * DM) + lane;
        f32x4 v0[4], v1[4]; unsigned y0[4][4], y1[4][4];
#pragma unroll
        for (int j = 0; j < 4; ++j) { { const u32x2 w0 = __builtin_nontemporal_load(x0 + 64 * j), w1 = __builtin_nontemporal_load(x1 + 64 * j); v0[j] = (f32x4){bflo(w0.x), bfhi(w0.x), bflo(w0.y), bfhi(w0.y)}; v1[j] = (f32x4){bflo(w1.x), bfhi(w1.x), bflo(w1.y), bfhi(w1.y)}; }
#pragma unroll
            for (int k = 0; k < 4; ++k) { y0[j][k] = __builtin_nontemporal_load((const unsigned*)(Y + (size_t)p0[k] * DM) + lane + 64 * j); y1[j][k] = __builtin_nontemporal_load((const unsigned*)(Y + (size_t)p1[k] * DM) + lane + 64 * j); } }
        float s0 = 0.f, s1 = 0.f;
#pragma unroll
        for (int j = 0; j < 4; ++j) {
#pragma unroll
            for (int k = 0; k < 4; ++k) {
                { const f32x2 lo = __builtin_amdgcn_cvt_pk_f32_fp8((int)y0[j][k], false), hi = __builtin_amdgcn_cvt_pk_f32_fp8((int)y0[j][k], true);
                  v0[j].x += g0[k] * lo.x; v0[j].y += g0[k] * lo.y; v0[j].z += g0[k] * hi.x; v0[j].w += g0[k] * hi.y; }
                { const f32x2 lo = __builtin_amdgcn_cvt_pk_f32_fp8((int)y1[j][k], false), hi = __builtin_amdgcn_cvt_pk_f32_fp8((int)y1[j][k], true);
                  v1[j].x += g1[k] * lo.x; v1[j].y += g1[k] * lo.y; v1[j].z += g1[k] * hi.x; v1[j].w += g1[k] * hi.y; } }
            s0 += (v0[j].x * v0[j].x + v0[j].y * v0[j].y) + (v0[j].z * v0[j].z + v0[j].w * v0[j].w);
            s1 += (v1[j].x * v1[j].x + v1[j].y * v1[j].y) + (v1[j].z * v1[j].z + v1[j].w * v1[j].w); }
        const float r0 = 1.0f / sqrtf(wave_sum(s0) * (1.0f / DM) + RMS_EPS), r1 = 1.0f / sqrtf(wave_sum(s1) * (1.0f / DM) + RMS_EPS);
#pragma unroll
        for (int j = 0; j < 4; ++j) { __builtin_nontemporal_store(v0[j] * r0 * gf[j], q0 + 64 * j); if (two) __builtin_nontemporal_store(v1[j] * r1 * gf[j], q1 + 64 * j); }
    }
}

#define XB_TMO      128
#define XB_XCNT(j)  (256  + 64 * (j))
#define XB_XSUB(j)  (1280 + 64 * (j))
#define XB_XGEN(j)  (2304 + 64 * (j))
#define XB_TOP      3328
#define XB_TOPGEN   3392
#define XCD_BAR_WORDS 3456
#define XB_SPIN_CAP (1u << 18)

__device__ __forceinline__ unsigned xb_ld(unsigned* p)              { return __hip_atomic_load(p, __ATOMIC_RELAXED, __HIP_MEMORY_SCOPE_AGENT); }
__device__ __forceinline__ unsigned xb_add(unsigned* p, unsigned v) { return __hip_atomic_fetch_add(p, v, __ATOMIC_RELAXED, __HIP_MEMORY_SCOPE_AGENT); }
__device__ __forceinline__ unsigned xb_xcc_id() { return (unsigned)__builtin_amdgcn_s_getreg((3 << 11) | 20) & 0xFu; }
#define XB_SPIN(cond, bar) do { unsigned _sp = 0; while (cond) { __builtin_amdgcn_s_sleep(1); \
    if ((++_sp & 255u) == 0u) { if (xb_ld(&(bar)[XB_TMO])) break; if (_sp > XB_SPIN_CAP) { atomicAdd(&(bar)[XB_TMO], 1u); break; } } } } while (0)

struct XcdBarrier {
    unsigned* bar; unsigned x;
    volatile LAS unsigned* st;
};

__device__ __forceinline__ XcdBarrier xcd_barrier_post(unsigned* bar, volatile LAS unsigned* st) {
    XcdBarrier b; b.bar = bar; b.x = xb_xcc_id(); b.st = st;
    if (threadIdx.x == 0) (void)xb_add(&bar[XB_XCNT(b.x)], 1u);
    return b;
}
__device__ __forceinline__ void xcd_barrier_complete(unsigned* bar, unsigned x, unsigned& nloc, unsigned& nx) {
    const unsigned G = gridDim.x * gridDim.y * gridDim.z;
    unsigned sum, cnt, mine, sp = 0u;
    for (;;) {
        sum = 0u; cnt = 0u; mine = 0u;
#pragma unroll
        for (unsigned j = 0; j < 16; ++j) { const unsigned c = xb_ld(&bar[XB_XCNT(j)]); sum += c; cnt += (c > 0u) ? 1u : 0u; mine = (j == x) ? c : mine; }
        if (sum == G) break;
        __builtin_amdgcn_s_sleep(1);
        if ((++sp & 255u) == 0u) { if (xb_ld(&bar[XB_TMO])) break; if (sp > XB_SPIN_CAP) { atomicAdd(&bar[XB_TMO], 1u); break; } }
    }
    nloc = mine > 0u ? mine : 1u; nx = cnt > 0u ? cnt : 1u;
}

__device__ __forceinline__ void xcd_barrier(const XcdBarrier& b) {
    asm volatile("s_waitcnt vmcnt(0)" ::: "memory");
    __syncthreads();
    if (threadIdx.x == 0) {
        unsigned* bar = b.bar;
        __builtin_amdgcn_s_waitcnt(0);
        unsigned nloc = b.st[0], nx = b.st[1];
        if (nloc == 0u) { xcd_barrier_complete(bar, b.x, nloc, nx); b.st[0] = nloc; b.st[1] = nx; }
        const unsigned old = xb_add(&bar[XB_XSUB(b.x)], 1u);
        const unsigned gen = old / nloc;
        if (old + 1u == (gen + 1u) * nloc) {
            __builtin_amdgcn_fence(__ATOMIC_RELEASE, "agent");
            asm volatile("s_waitcnt vmcnt(0)" ::: "memory");
            const unsigned og = xb_add(&bar[XB_TOP], 1u);
            const unsigned tg = og / nx;
            if (og + 1u == (tg + 1u) * nx) xb_add(&bar[XB_TOPGEN], 1u);
            else XB_SPIN(xb_ld(&bar[XB_TOPGEN]) == tg, bar);
            __builtin_amdgcn_fence(__ATOMIC_ACQUIRE, "agent");
            xb_add(&bar[XB_XGEN(b.x)], 1u);
            asm volatile("s_waitcnt vmcnt(0)" ::: "memory");
        } else {
            XB_SPIN(xb_ld(&bar[XB_XGEN(b.x)]) == gen, bar);
            __builtin_amdgcn_fence(__ATOMIC_ACQUIRE, "agent");
            asm volatile("s_waitcnt vmcnt(0)" ::: "memory");
        }
    }
    __syncthreads();
}


constexpr int NPHASE = 11;
__global__ void __launch_bounds__(NTHR, 2) fwd_kernel(Args a_) {
    extern __shared__ __attribute__((aligned(16))) unsigned char lds_raw[];
    cg::grid_group grid = cg::this_grid();
    Frame F; F.lds = (LAS unsigned char*)lds_raw; F.G = gridDim.x; F.bid = blockIdx.x;
    if (kargs()->ph_lo < 0) grid.sync();
    volatile LAS unsigned* bar_st = (volatile LAS unsigned*)(F.lds + LDS_BYTES - 16);
    if (threadIdx.x < 2) bar_st[threadIdx.x] = 0u;
    __syncthreads();
    const XcdBarrier xbar = xcd_barrier_post((unsigned*)(kargs()->ws + WS_CTL) + CW_BAR, bar_st);
#define REFRAME() do { int t_ = threadIdx.x; asm volatile("" : "+v"(t_)); F.tid = t_; F.lane = t_ & 63; F.wave = __builtin_amdgcn_readfirstlane(t_ >> 6); } while (0)
    REFRAME();
    const int lo = kargs()->ph_lo, hi = kargs()->ph_hi;
#define a (*kargs())
#define ws (kargs()->ws)
#ifndef PHMASK
#define PHMASK 0x7ff
#endif
#define IN(k) (((PHMASK >> (k)) & 1) && lo <= (k) && (k) < hi)
#define STAMP(k) do { if (TIMING_A >= 0 && blockIdx.x == 0 && threadIdx.x == 0) ((unsigned long long*)(ws + WS_CTL + 2048))[k] = __builtin_amdgcn_s_memrealtime(); } while (0)
#define REP(k) for (int rep_ = 0; rep_ < (((DOUBLE_MASK >> (k)) & 1) ? 2 : 1); ++rep_, (((DOUBLE_MASK >> (k)) & 1) && rep_ == 1 ? xcd_barrier(xbar) : (void)0))
#define SEAM(k) do { if (IN(k) && IN((k) + 1)) xcd_barrier(xbar); STAMP((k) + 1); } while (0)
    STAMP(0);
#ifndef P0_VAR
#define P0_VAR 7
#endif
    REFRAME(); REP(0) if (IN(0)) p0_prologue(F, a, rep_ == 0 ? 7 : P0_VAR);
    SEAM(0);
    REFRAME(); if (IN(1)) {
        pg8::Gemm g{ws + WS_XN, ws + WS_WIN, DM, 0};
        pg8::StaticOrder S; S.init(NTOK, PW, F.G, F.bid, ((DOUBLE_MASK >> 1) & 1) + 1);
        pg8::EpiProj E{(bf16_t*)(ws + WS_PROJ), (const float*)(ws + WS_ROPE)};
        pg8::gemm_phase<2, false>(F.lds, g, S, E);
    }
    SEAM(1);
    REFRAME(); REP(2) if (IN(2)) p2_ret_kv(F, a);
    SEAM(2);
    REFRAME(); REP(3) if (IN(3)) p3_ret_scan(F, a);
    SEAM(3);
    REFRAME(); if (IN(4)) p4_mixers(F, a);
    SEAM(4);
    REFRAME(); if (IN(5)) {
        pg8::Gemm g{ws + WS_MIX, ws + WS_WO, DM, 0};
        pg8::StaticOrder S; S.init(NTOK, DM, F.G, F.bid, ((DOUBLE_MASK >> 5) & 1) + 1);
        pg8::EpiRes E{a.x, (bf16_t*)(ws + WS_X1B)};
        pg8::gemm_phase<2, false>(F.lds, g, S, E);
    }
    SEAM(5);
    REFRAME(); REP(6) if (IN(6)) p6_router(F, a);
    SEAM(6);
    REFRAME(); REP(7) if (IN(7)) p7_scatter(F, a);
    SEAM(7);
    REFRAME(); if (IN(8)) {
        const int ntiles = build_tile_table(F, a);
        pg8::Gemm g{ws + WS_H2, ws + WS_WMI, DM, (size_t)2 * FF * DM};
        pg8::GroupedOrder S{ntiles, 8, ntiles * 8, F.G, F.bid, F.lds + LDS_MISC, ((DOUBLE_MASK >> 8) & 1) + 1};
        pg8::EpiSwiglu E{ws + WS_ACT, a.b_moe_in};
        build_row_table(F, a, S);
        pg8::gemm_phase<1, true>(F.lds, g, S, E);
    }
    SEAM(8);
    REFRAME(); if (IN(9)) {
        const int ntiles = build_tile_table(F, a);
        pg8::Gemm g{ws + WS_ACT, ws + WS_WMO, FF, (size_t)DM * FF};
        pg8::GroupedOrder S{ntiles, 4, ntiles * 4, F.G, F.bid, F.lds + LDS_MISC, ((DOUBLE_MASK >> 9) & 1) + 1};
        pg8::EpiY E{ws + WS_Y, a.b_moe_out};
        pg8::gemm_phase<1, false>(F.lds, g, S, E);
    }
    SEAM(9);
    REFRAME(); REP(10) if (IN(10)) p10_final(F, a);
    if (TIMING_A >= 0) {
        grid.sync(); STAMP(11); grid.sync();
        const unsigned long long* ts = (const unsigned long long*)(ws + WS_CTL + 2048);
        const float ta = (float)(ts[TIMING_A + 1] - ts[TIMING_A]) * 0.01f, tb = (float)(ts[TIMING_B + 1] - ts[TIMING_B]) * 0.01f;
        for (size_t i = (size_t)blockIdx.x * NTHR + threadIdx.x; i < (size_t)NTOK * DM; i += (size_t)gridDim.x * NTHR)
            a.out[i] = (i == 0) ? 4.0f * ta : ((i >= 1024 && i < 1024 + (1u << 22)) ? tb : 0.f);
    }
#undef IN
#undef SEAM
#undef a
#undef ws
}

#ifndef N_LAUNCHES
#define N_LAUNCHES 1
#endif
extern "C" void kernel_launch(void* const* d_in, const int* in_sizes, int n_in, void* d_out, int out_size, void* d_ws, size_t ws_size, hipStream_t stream) {
    static int grid = 0;
    if (grid == 0) {
        if (n_in != 19 || out_size != NTOK * DM || ws_size < WS_END) { fprintf(stderr, "kernel_launch: unexpected shapes (n_in %d out %d ws %zu)\n", n_in, out_size, ws_size); grid = -1; return; }
        int dev = 0, cus = 0, per_cu = 0;
        if (hipGetDevice(&dev) != hipSuccess || hipDeviceGetAttribute(&cus, hipDeviceAttributeMultiprocessorCount, dev) != hipSuccess) { grid = -1; return; }
        if (hipFuncSetAttribute((const void*)fwd_kernel, hipFuncAttributeMaxDynamicSharedMemorySize, LDS_BYTES) != hipSuccess) { fprintf(stderr, "kernel_launch: hipFuncSetAttribute failed\n"); grid = -1; return; }
        if (hipOccupancyMaxActiveBlocksPerMultiprocessor(&per_cu, (const void*)fwd_kernel, NTHR, LDS_BYTES) != hipSuccess || per_cu < 1) { fprintf(stderr, "kernel_launch: occupancy query says %d\n", per_cu); grid = -1; return; }
        grid = cus;
    }
    if (grid < 0) return;
    (void)hipMemsetAsync((char*)d_ws + WS_CTL, 0, CTL_ZERO_BYTES, stream);
    Args a{};
    a.x = (const float*)d_in[0]; a.positions = (const int*)d_in[1]; a.norm1_g = (const float*)d_in[2]; a.w_in = (const float*)d_in[3];
    a.lq1 = (const float*)d_in[4]; a.lk1 = (const float*)d_in[5]; a.lq2 = (const float*)d_in[6]; a.lk2 = (const float*)d_in[7];
    a.diff_g = (const float*)d_in[8]; a.ret_g = (const float*)d_in[9]; a.w_o = (const float*)d_in[10]; a.norm2_g = (const float*)d_in[11];
    a.w_router = (const float*)d_in[12]; a.b_router = (const float*)d_in[13]; a.w_moe_in = (const float*)d_in[14]; a.b_moe_in = (const float*)d_in[15];
    a.w_moe_out = (const float*)d_in[16]; a.b_moe_out = (const float*)d_in[17]; a.norm_f_g = (const float*)d_in[18];
    a.out = (float*)d_out; a.ws = (unsigned char*)d_ws;
    if (N_LAUNCHES == 1) {
        a.ph_lo = 0; a.ph_hi = NPHASE;
        void* args[] = {&a};
        hipError_t e = hipLaunchCooperativeKernel((const void*)fwd_kernel, dim3(grid), dim3(NTHR), args, LDS_BYTES, stream);
        if (e != hipSuccess) fprintf(stderr, "cooperative launch failed: %s\n", hipGetErrorString(e));
    } else {
        for (int p = 0; p < NPHASE; ++p) {
            a.ph_lo = p; a.ph_hi = p + 1;
            void* args[] = {&a};
            hipError_t e = hipLaunchCooperativeKernel((const void*)fwd_kernel, dim3(grid), dim3(NTHR), args, LDS_BYTES, stream);
            if (e != hipSuccess) { fprintf(stderr, "cooperative launch %d failed: %s\n", p, hipGetErrorString(e)); break; }
        }
    }
}
```

```cpp
#include <hip/hip_runtime.h>
#include <hip/hip_cooperative_groups.h>
#include <cstdio>
#include <cstdint>
namespace cg = cooperative_groups;
#ifndef TIMING_A
#define TIMING_A -1
#endif
#ifndef TIMING_B
#define TIMING_B -1
#endif
#ifndef DOUBLE_MASK
#define DOUBLE_MASK 0
#endif

#define LAS __attribute__((address_space(3)))
typedef unsigned short bf16_t;
typedef short bf16x8 __attribute__((ext_vector_type(8)));
typedef short s16x4 __attribute__((ext_vector_type(4)));
typedef float f32x4 __attribute__((ext_vector_type(4)));
typedef float f32x2 __attribute__((ext_vector_type(2)));
typedef float f32x16 __attribute__((ext_vector_type(16)));
typedef unsigned u32x4 __attribute__((ext_vector_type(4)));
typedef unsigned u32x2 __attribute__((ext_vector_type(2)));

constexpr int NB = 4, SEQ = 8192, DM = 1024, NTOK = NB * SEQ;
constexpr int PW = 3072;
constexpr int C_DQ = 0, C_DK = 512, C_DV = 1024, C_RQ = 1536, C_RK = 1792, C_RV = 2048, C_RG = 2560;
constexpr int NEXP = 32, TOPK = 4, FF = 1024;
constexpr int NCH = SEQ / 128;
constexpr int MAXTILES = (NTOK * TOPK) / 256 + NEXP;
constexpr float RMS_EPS = 1e-5f;
constexpr float LOG2E = 1.4426950408889634f;
constexpr float QSCALE = 0.125f * LOG2E;

constexpr size_t MiB = 1u << 20;
constexpr size_t WS_CTL = 0, CTL_ZERO_BYTES = 32768;
constexpr int CW_BAR = 4096;
constexpr size_t WS_ROWLIST = 131072;
constexpr size_t WS_HIST = 65536;
constexpr size_t WS_WIN = 2 * MiB;
constexpr size_t WS_WO = 8 * MiB;
constexpr size_t WS_WMI = 10 * MiB;
constexpr size_t WS_WMO = 138 * MiB;
constexpr size_t WS_ROPE = 202 * MiB;
constexpr size_t WS_TOPK = 210 * MiB;
constexpr size_t WS_A = 212 * MiB;
constexpr size_t WS_XN = WS_A, WS_PROJ = WS_A + 64 * MiB, WS_H2 = WS_A, WS_Y = WS_A;
constexpr size_t WS_B = 484 * MiB;
constexpr size_t WS_MIX = WS_B, WS_KVT = WS_B + 64 * MiB, WS_PREVT = WS_B + 96 * MiB, WS_ACT = WS_B;
constexpr size_t WS_VT8 = WS_B + 112 * MiB;
constexpr size_t WS_X1B = 628 * MiB;
constexpr size_t WS_END = 756 * MiB;
constexpr int CW_CNT = 0;

constexpr int LDS_BYTES = 155648;
constexpr int LDS_MISC = 131072;
constexpr int LDS_ROWTAB = LDS_MISC + 1024, ROWTAB_UNITS = 18;
constexpr int NTHR = 512, NWAVES = 8;

__device__ __forceinline__ unsigned f2bf(float f) { unsigned u = __builtin_bit_cast(unsigned, f); return (u + 0x7fffu + ((u >> 16) & 1u)) >> 16; }
__device__ __forceinline__ unsigned pk2(float lo, float hi) { return f2bf(lo) | (f2bf(hi) << 16); }
__device__ __forceinline__ float bf2f(unsigned short b) { return __builtin_bit_cast(float, (unsigned)b << 16); }
__device__ __forceinline__ float bflo(unsigned w) { return __builtin_bit_cast(float, w << 16); }
__device__ __forceinline__ float bfhi(unsigned w) { return __builtin_bit_cast(float, w & 0xffff0000u); }
__device__ __forceinline__ float wave_sum(float v) {
#pragma unroll
    for (int o = 1; o < 64; o <<= 1) v += __shfl_xor(v, o);
    return v;
}
__device__ __forceinline__ int crow(int r, int hi) { return (r & 3) + 8 * (r >> 2) + 4 * hi; }
__device__ __forceinline__ s16x4 tr_read(const LAS unsigned char* p) {
    typedef short v4i16_t __attribute__((ext_vector_type(4)));
    return __builtin_bit_cast(s16x4, __builtin_amdgcn_ds_read_tr16_b64_v4i16((LAS v4i16_t*)p));
}
__device__ __forceinline__ bf16x8 cat8(s16x4 lo, s16x4 hi) { return (bf16x8){lo[0], lo[1], lo[2], lo[3], hi[0], hi[1], hi[2], hi[3]}; }
__device__ __forceinline__ bf16x8 pack8(const f32x16& p, int b) {
    u32x4 w; w.x = pk2(p[b], p[b + 1]); w.y = pk2(p[b + 2], p[b + 3]); w.z = pk2(p[b + 4], p[b + 5]); w.w = pk2(p[b + 6], p[b + 7]);
    return __builtin_bit_cast(bf16x8, w);
}
#define MFMA32(a, b, c) __builtin_amdgcn_mfma_f32_32x32x16_bf16((a), (b), (c), 0, 0, 0)
typedef int v8i __attribute__((ext_vector_type(8)));
__device__ __forceinline__ unsigned pk4_fp8(float a, float b, float c, float d) { int w = 0; w = __builtin_amdgcn_cvt_pk_fp8_f32(a, b, w, false); w = __builtin_amdgcn_cvt_pk_fp8_f32(c, d, w, true); return (unsigned)w; }
constexpr float W8_SCALE = 32.0f;
constexpr float ACT8_SCALE = 4.0f;

namespace pg8 {
constexpr int BM = 256, BK = 64, HALF = 128, HTB = HALF * BK * 2, STAGE_BYTES = 8 * HTB, NXCD = 8;
__host__ __device__ __forceinline__ int lds_byte(int r, int c) { const int st = (r >> 4) * 2 + (c >> 5), rr = r & 15, cc = c & 31, ob = rr * 64 + cc * 2; return st * 1024 + (ob ^ (((ob >> 9) & 1) << 5)); }
__host__ __device__ __forceinline__ void stage_rc(int b, int& R, int& C) { const int st = b / 1024, sb = b % 1024, swz = sb ^ (((sb >> 9) & 1) << 5); R = (st >> 1) * 16 + swz / 64; C = (st & 1) * 32 + (swz % 64) / 2; }
__host__ __device__ __forceinline__ int g8(int k) { return k ^ ((k >= 2 && k <= 5) ? 2 : 0); }
__host__ __device__ __forceinline__ int lds_byte8(int r, int s) { return (r >> 4) * 2048 + (r & 15) * 128 + ((s ^ g8((r & 15) >> 1)) << 4); }
__host__ __device__ __forceinline__ void stage_rc8(int b, int& R, int& CB) { const int blk = b / 2048, rr = (b % 2048) / 128, sl = (b % 128) / 16; R = blk * 16 + rr; CB = (sl ^ g8(rr >> 1)) * 16; }
__host__ __device__ __forceinline__ int perm32(int rho) { const int n = rho >> 4, i = rho & 15; return 8 * (i >> 2) + 4 * n + (i & 3); }

struct Unit { int pm, pn, e; };
struct Gemm { const void* A; const void* Bt; int K; size_t estride; };

struct StaticOrder {
    int nM, nN, nwg, G, c, rep;
    __device__ void init(int M, int N, int G_, int c_, int rep_ = 1) { nM = M / BM; nN = N / BM; nwg = nM * nN; G = G_; c = c_; rep = rep_; }
    __device__ bool next(int i, Unit& u) const {
        const long L = (long)i * G + c; if (L >= (long)nwg * rep) return false;
        int wgid = (int)(L >= nwg ? L - nwg : L); { const int q = nwg / NXCD, r = nwg % NXCD, xcd = wgid % NXCD, off = wgid / NXCD; wgid = (xcd < r ? xcd * (q + 1) : r * (q + 1) + (xcd - r) * q) + off; }
        const int nig = 8 * nN, gid = wgid / nig, fm = gid * 8, gsz = (nM - fm) < 8 ? (nM - fm) : 8;
        u.pm = fm + ((wgid % nig) % gsz); u.pn = (wgid % nig) / gsz; u.e = 0; return true;
    }
};
struct GroupedOrder {
    int ntiles, nN, nwg, G, c; const LAS unsigned char* tile_e; int rep;
    __device__ bool next(int i, Unit& u) const {
        const long L = (long)i * G + c; if (L >= (long)nwg * rep) return false;
        int wgid = (int)(L >= nwg ? L - nwg : L); { const int q = nwg / NXCD, r = nwg % NXCD, xcd = wgid % NXCD, off = wgid / NXCD; wgid = (xcd < r ? xcd * (q + 1) : r * (q + 1) + (xcd - r) * q) + off; }
        u.pm = wgid / nN; u.pn = wgid % nN; u.e = __builtin_amdgcn_readfirstlane((int)tile_e[u.pm]); return true;
    }
};

__device__ __forceinline__ unsigned cvt_pk_bf16(float lo, float hi) { unsigned r; asm volatile("v_cvt_pk_bf16_f32 %0, %1, %2" : "=v"(r) : "v"(lo), "v"(hi)); return r; }

struct EpiProj {
    static constexpr bool PERM = true;
    bf16_t* O; const float* rope;
    __device__ __forceinline__ void operator()(const f32x4 (&acc)[2][2][4][2], const Unit& u, int wr, int wc, int fr, int fq) const {
        const int pn = u.pn;
        const bool isrope = (pn < 4) || pn == 6 || pn == 7;
        const float sc = (pn < 2) ? QSCALE : (pn == 7 ? 0.125f : 1.0f);
        const int row0 = u.pm * BM + wr * 64 + fr, col0 = pn * BM + wc * 32 + 8 * fq, ri = 16 * (wc & 1) + 4 * fq;
#pragma unroll
        for (int ai = 0; ai < 2; ++ai)
#pragma unroll
            for (int m = 0; m < 4; ++m) {
                const int row = row0 + ai * HALF + m * 16;
                bf16_t* rowp = O + (size_t)row * PW + col0;
                f32x4 cs = (f32x4){1.f, 1.f, 1.f, 1.f}, sn = (f32x4){0.f, 0.f, 0.f, 0.f};
                if (isrope) { cs = *(const f32x4*)(rope + (size_t)row * 64 + ri); sn = *(const f32x4*)(rope + (size_t)row * 64 + 32 + ri); }
#pragma unroll
                for (int bj = 0; bj < 2; ++bj) {
                    const f32x4 a0 = acc[ai][bj][m][0], a1 = acc[ai][bj][m][1];
                    f32x4 v0 = (a0 * cs - a1 * sn) * sc, v1 = (a1 * cs + a0 * sn) * sc;
                    u32x4 w; w.x = cvt_pk_bf16(v0[0], v0[1]); w.y = cvt_pk_bf16(v0[2], v0[3]); w.z = cvt_pk_bf16(v1[0], v1[1]); w.w = cvt_pk_bf16(v1[2], v1[3]);
                    *(u32x4*)(rowp + bj * HALF) = w;
                }
                asm volatile("" ::: "memory");
            }
    }
};
struct EpiRes {
    static constexpr bool PERM = true;
    const float* X; bf16_t* O;
    __device__ __forceinline__ void operator()(const f32x4 (&acc)[2][2][4][2], const Unit& u, int wr, int wc, int fr, int fq) const {
        const int row0 = u.pm * BM + wr * 64 + fr, col0 = u.pn * BM + wc * 32 + 8 * fq;
#pragma unroll
        for (int ai = 0; ai < 2; ++ai)
#pragma unroll
            for (int m = 0; m < 4; ++m) {
                const size_t off = (size_t)(row0 + ai * HALF + m * 16) * DM + col0;
#pragma unroll
                for (int bj = 0; bj < 2; ++bj) { const f32x4 x0 = __builtin_nontemporal_load((const f32x4*)(X + off + bj * HALF)), x1 = __builtin_nontemporal_load((const f32x4*)(X + off + bj * HALF + 4));
                    const f32x4 v0 = x0 + acc[ai][bj][m][0], v1 = x1 + acc[ai][bj][m][1];
                    u32x4 w; w.x = cvt_pk_bf16(v0[0], v0[1]); w.y = cvt_pk_bf16(v0[2], v0[3]); w.z = cvt_pk_bf16(v1[0], v1[1]); w.w = cvt_pk_bf16(v1[2], v1[3]);
                    *(u32x4*)(O + off + bj * HALF) = w; }
                if (m & 1) asm volatile("" ::: "memory");
            }
    }
};
struct EpiSwiglu {
    static constexpr bool PERM = true;
    unsigned char* O; const float* bias;
    __device__ __forceinline__ void operator()(const f32x4 (&acc)[2][2][4][2], const Unit& u, int wr, int wc, int fr, int fq) const {
        const int row0 = u.pm * BM + wr * 64 + fr, a0 = u.pn * 128 + wc * 32 + 8 * fq;
        f32x4 bg[2], bl[2];
        { const float* bp = bias + (size_t)u.e * 2048 + 2 * a0;
#pragma unroll
          for (int n = 0; n < 2; ++n) { const f32x4 t0 = *(const f32x4*)(bp + 8 * n), t1 = *(const f32x4*)(bp + 8 * n + 4);
              bg[n] = (f32x4){t0[0], t0[2], t1[0], t1[2]}; bl[n] = (f32x4){t0[1], t0[3], t1[1], t1[3]}; } }
#pragma unroll
        for (int ai = 0; ai < 2; ++ai)
#pragma unroll
            for (int m = 0; m < 4; ++m) {
                unsigned char* rowp = O + (size_t)(row0 + ai * HALF + m * 16) * FF + a0;
                u32x2 w;
#pragma unroll
                for (int n = 0; n < 2; ++n) {
                    const f32x4 ga = acc[ai][0][m][n], la = acc[ai][1][m][n];
                    f32x2 o2[2];
#pragma unroll
                    for (int p = 0; p < 2; ++p) {
                        f32x2 g = (f32x2){ga[2 * p], ga[2 * p + 1]} * (1.0f / W8_SCALE) + (f32x2){bg[n][2 * p], bg[n][2 * p + 1]};
                        f32x2 l = (f32x2){la[2 * p], la[2 * p + 1]} * (1.0f / W8_SCALE) + (f32x2){bl[n][2 * p], bl[n][2 * p + 1]};
                        g.x = fminf(g.x, 7.0f); g.y = fminf(g.y, 7.0f);
                        l.x = __builtin_amdgcn_fmed3f(l.x, -7.0f, 7.0f); l.y = __builtin_amdgcn_fmed3f(l.y, -7.0f, 7.0f);
                        const f32x2 t = g * (-1.702f * LOG2E);
                        f32x2 e; e.x = __builtin_amdgcn_exp2f(t.x); e.y = __builtin_amdgcn_exp2f(t.y);
                        const f32x2 d = e + 1.0f;
                        f32x2 r; r.x = __builtin_amdgcn_rcpf(d.x); r.y = __builtin_amdgcn_rcpf(d.y);
                        o2[p] = (g * r) * (l * ACT8_SCALE + ACT8_SCALE);
                    }
                    w[n] = pk4_fp8(o2[0].x, o2[0].y, o2[1].x, o2[1].y);
                }
                *(u32x2*)rowp = w;
                asm volatile("" ::: "memory");
            }
    }
};
struct EpiY {
    static constexpr bool PERM = true;
    unsigned char* O; const float* bias;
    __device__ __forceinline__ void operator()(const f32x4 (&acc)[2][2][4][2], const Unit& u, int wr, int wc, int fr, int fq) const {
        const int row0 = u.pm * BM + wr * 64 + fr, col0 = u.pn * BM + wc * 32 + 8 * fq;
        constexpr float SC = 1.0f / (W8_SCALE * ACT8_SCALE);
        f32x4 bv[2][2];
#pragma unroll
        for (int bj = 0; bj < 2; ++bj)
#pragma unroll
            for (int n = 0; n < 2; ++n) bv[bj][n] = *(const f32x4*)(bias + (size_t)u.e * DM + col0 + bj * HALF + 4 * n);
#pragma unroll
        for (int ai = 0; ai < 2; ++ai)
#pragma unroll
            for (int m = 0; m < 4; ++m) {
                unsigned char* rowp = O + (size_t)(row0 + ai * HALF + m * 16) * DM + col0;
#pragma unroll
                for (int bj = 0; bj < 2; ++bj) {
                    const f32x4 v0 = acc[ai][bj][m][0] * SC + bv[bj][0], v1 = acc[ai][bj][m][1] * SC + bv[bj][1];
                    u32x2 w; w.x = pk4_fp8(v0[0], v0[1], v0[2], v0[3]); w.y = pk4_fp8(v1[0], v1[1], v1[2], v1[3]);
                    *(u32x2*)(rowp + bj * HALF) = w;
                }
                asm volatile("" ::: "memory");
            }
    }
};

template <int ES, bool GATHER, class Epi, class Sched>
__device__ __forceinline__ void gemm_phase(LAS unsigned char* lds, const Gemm g, const Sched& S, const Epi& E) {
    int tid = threadIdx.x; asm volatile("" : "+v"(tid));
    const int wid = __builtin_amdgcn_readfirstlane(tid >> 6), lane = tid & 63, wr = wid >> 2, wc = wid & 3, fr = lane & 15, fq = lane >> 4;
    const int KB = g.K * ES, nt = KB / (BK * 2);
    unsigned voffA[2], voffB[2];
#pragma unroll
    for (int i = 0; i < 2; ++i) { int R, CB; if constexpr (ES == 2) { stage_rc(tid * 16 + i * 8192, R, CB); CB *= 2; } else stage_rc8(tid * 16 + i * 8192, R, CB);
        const int Rb = Epi::PERM ? ((R & ~31) + perm32(R & 31)) : R;
        voffA[i] = (unsigned)(R * KB + CB); voffB[i] = (unsigned)(Rb * KB + CB); }
    const size_t kstep = (size_t)(BK * 2);
    const size_t hstep = (size_t)HALF * KB;
    const size_t tstep = 2 * hstep;
    const unsigned ldsw = (unsigned)wid * 1024u;
    const int aoff = (ES == 2) ? lds_byte(wr * 64 + fr, fq * 8) : lds_byte8(wr * 64 + fr, 2 * fq), boff = (ES == 2) ? lds_byte(wc * 32 + fr, fq * 8) : lds_byte8(wc * 32 + fr, 2 * fq);
    const int aoff2 = lds_byte8(wr * 64 + fr, 2 * fq + 1), boff2 = lds_byte8(wc * 32 + fr, 2 * fq + 1);
    const int mx_one = 0x7f7f7f7f;
#define PG8_SA(b, h) (((b) * 2 + (h)) * HTB)
#define PG8_SB(b, h) ((4 + (b) * 2 + (h)) * HTB)
#define PG8_STAGE(bufoff, gbase, voff) do { _Pragma("unroll") for (int _i = 0; _i < 2; ++_i) \
        __builtin_amdgcn_global_load_lds((const unsigned*)((const char*)(gbase) + (voff)[_i]), (LAS unsigned*)(lds + (bufoff) + ldsw + _i * 8192), 16, 0, 0); } while (0)
    unsigned vA0[2], vA1[2], nA0[2], nA1[2];
    const LAS unsigned* rtab = (const LAS unsigned*)(lds + LDS_ROWTAB);
#define PG8_ROWS(ui_, d0, d1) do { _Pragma("unroll") for (int _i = 0; _i < 2; ++_i) { int R_, C_; if constexpr (ES == 2) { stage_rc(tid * 16 + _i * 8192, R_, C_); C_ *= 2; } else stage_rc8(tid * 16 + _i * 8192, R_, C_); \
        d0[_i] = rtab[(ui_) * 256 + R_] + (unsigned)C_; d1[_i] = rtab[(ui_) * 256 + 128 + R_] + (unsigned)C_; } } while (0)
#define PG8_STGA(bufoff, ptr, koff, h, nx) do { if constexpr (GATHER) { PG8_STAGE(bufoff, (const char*)g.A + (koff), (nx) ? ((h) ? nA1 : nA0) : ((h) ? vA1 : vA0)); } \
        else { PG8_STAGE(bufoff, (ptr) + (h) * hstep, voffA); } } while (0)
#define PG8_CAT8(lo, hi) __builtin_bit_cast(v8i, __builtin_shufflevector((lo), (hi), 0, 1, 2, 3, 4, 5, 6, 7))
#define PG8_LDA(dst, b, h) do { if constexpr (ES == 2) { _Pragma("unroll") for (int m = 0; m < 4; ++m) _Pragma("unroll") for (int k = 0; k < 2; ++k) dst[m][k] = *(const LAS bf16x8*)(lds + PG8_SA(b, h) + aoff + m * 2048 + k * 1024); } \
        else { _Pragma("unroll") for (int m = 0; m < 4; ++m) dst##8[m] = PG8_CAT8(*(const LAS u32x4*)(lds + PG8_SA(b, h) + aoff + m * 2048), *(const LAS u32x4*)(lds + PG8_SA(b, h) + aoff2 + m * 2048)); } } while (0)
#define PG8_LDB(dst, b, h) do { if constexpr (ES == 2) { _Pragma("unroll") for (int n = 0; n < 2; ++n) _Pragma("unroll") for (int k = 0; k < 2; ++k) dst[n][k] = *(const LAS bf16x8*)(lds + PG8_SB(b, h) + boff + n * 2048 + k * 1024); } \
        else { _Pragma("unroll") for (int n = 0; n < 2; ++n) dst##8[n] = PG8_CAT8(*(const LAS u32x4*)(lds + PG8_SB(b, h) + boff + n * 2048), *(const LAS u32x4*)(lds + PG8_SB(b, h) + boff2 + n * 2048)); } } while (0)
#define PG8_MMA(ai, bj, At, Bt) do { __builtin_amdgcn_s_setprio(1); \
        if constexpr (ES == 2) { _Pragma("unroll") for (int m = 0; m < 4; ++m) _Pragma("unroll") for (int n = 0; n < 2; ++n) _Pragma("unroll") for (int k = 0; k < 2; ++k) \
            acc[ai][bj][m][n] = __builtin_amdgcn_mfma_f32_16x16x32_bf16(Bt[n][k], At[m][k], acc[ai][bj][m][n], 0, 0, 0); } \
        else { _Pragma("unroll") for (int m = 0; m < 4; ++m) _Pragma("unroll") for (int n = 0; n < 2; ++n) \
            asm volatile("v_mfma_scale_f32_16x16x128_f8f6f4 %0, %1, %2, %0, %3, %3 op_sel_hi:[0,0,0]" : "+v"(acc[ai][bj][m][n]) : "v"(Bt##8[n]), "v"(At##8[m]), "v"(mx_one)); } \
        __builtin_amdgcn_s_setprio(0); } while (0)
#define PG8_WAIT_V(n) asm volatile("s_waitcnt vmcnt(" #n ")" ::: "memory")
#define PG8_WAIT_L(n) asm volatile("s_waitcnt lgkmcnt(" #n ")" ::: "memory")
#define PG8_BAR __builtin_amdgcn_s_barrier()
#define PG8_SCHED __builtin_amdgcn_sched_barrier(0)
    Unit cur, nxt; int ui = 0;
    if (!S.next(0, cur)) return;
    f32x4 acc[2][2][4][2];
#pragma unroll
    for (int a = 0; a < 2; ++a)
#pragma unroll
        for (int b = 0; b < 2; ++b)
#pragma unroll
            for (int m = 0; m < 4; ++m)
#pragma unroll
                for (int n = 0; n < 2; ++n) acc[a][b][m][n] = (f32x4){0.f, 0.f, 0.f, 0.f};
    bf16x8 At[4][2], B0[2][2], B1[2][2];
    v8i At8[4], B08[2], B18[2];
    const char* cA = (const char*)g.A + (size_t)cur.pm * tstep; const char* cB = (const char*)g.Bt + (size_t)cur.e * g.estride + (size_t)cur.pn * tstep;
    if constexpr (GATHER) { PG8_ROWS(0, vA0, vA1); }
    PG8_STAGE(PG8_SB(0, 0), cB, voffB); PG8_STAGE(PG8_SB(0, 1), cB + hstep, voffB); PG8_STGA(PG8_SA(0, 0), cA, 0, 0, false); PG8_STGA(PG8_SA(0, 1), cA, 0, 1, false);
    if (wr == 1) PG8_BAR;
    PG8_WAIT_V(2); PG8_BAR;
    PG8_STAGE(PG8_SB(1, 0), cB + kstep, voffB); PG8_STGA(PG8_SA(1, 0), cA + kstep, kstep, 0, false); PG8_STAGE(PG8_SB(1, 1), cB + hstep + kstep, voffB);
    PG8_WAIT_V(6); PG8_BAR;
    for (;;) {
        const bool has_next = S.next(ui + 1, nxt);
        if constexpr (GATHER) { if (has_next) { PG8_ROWS(ui + 1, nA0, nA1); } else { _Pragma("unroll") for (int _i = 0; _i < 2; ++_i) { nA0[_i] = vA0[_i]; nA1[_i] = vA1[_i]; } } }
        const char* nA = has_next ? (const char*)g.A + (size_t)nxt.pm * tstep : cA; const char* nB = has_next ? (const char*)g.Bt + (size_t)nxt.e * g.estride + (size_t)nxt.pn * tstep : cB;
#pragma nounroll
        for (int t = 0; t < nt; t += 2) {
            asm volatile("" : "+v"(voffA[0]), "+v"(voffA[1]), "+v"(voffB[0]), "+v"(voffB[1]));
            const bool last = (t == nt - 2);
            const char* a1 = cA + (size_t)(t + 1) * kstep;
            const char* a2 = last ? nA : cA + (size_t)(t + 2) * kstep; const char* b2 = last ? nB : cB + (size_t)(t + 2) * kstep;
            const char* a3 = a2 + kstep; const char* b3 = b2 + kstep;
            const size_t k1 = (size_t)(t + 1) * kstep, k2 = last ? (size_t)0 : (size_t)(t + 2) * kstep, k3 = k2 + kstep;
            PG8_LDB(B0, 0, 0); PG8_LDB(B1, 0, 1); PG8_SCHED; PG8_LDA(At, 0, 0); PG8_STGA(PG8_SA(1, 1), a1, k1, 1, false);
            PG8_WAIT_V(8); PG8_WAIT_L(0); PG8_BAR; PG8_MMA(0, 0, At, B0); PG8_MMA(0, 1, At, B1); PG8_BAR; PG8_SCHED;
            PG8_LDA(At, 0, 1); PG8_STAGE(PG8_SB(0, 0), b2, voffB); PG8_STAGE(PG8_SB(0, 1), b2 + hstep, voffB); PG8_STGA(PG8_SA(0, 0), a2, k2, 0, last);
            PG8_WAIT_V(8); PG8_WAIT_L(0); PG8_BAR; PG8_MMA(1, 0, At, B0); PG8_MMA(1, 1, At, B1); PG8_BAR; PG8_SCHED;
            PG8_LDB(B0, 1, 0); PG8_LDB(B1, 1, 1); PG8_SCHED; PG8_LDA(At, 1, 0); PG8_STGA(PG8_SA(0, 1), a2, k2, 1, last);
            PG8_WAIT_V(8); PG8_WAIT_L(0); PG8_BAR; PG8_MMA(0, 0, At, B0); PG8_MMA(0, 1, At, B1); PG8_BAR; PG8_SCHED;
            PG8_LDA(At, 1, 1); PG8_STAGE(PG8_SB(1, 0), b3, voffB); PG8_STAGE(PG8_SB(1, 1), b3 + hstep, voffB); PG8_STGA(PG8_SA(1, 0), a3, k3, 0, last);
            PG8_WAIT_V(8); PG8_WAIT_L(0); PG8_BAR; PG8_MMA(1, 0, At, B0); PG8_MMA(1, 1, At, B1); PG8_BAR; PG8_SCHED;
        }
        if (wr == 0) PG8_BAR;
        if constexpr (ES == 1) asm volatile("s_nop 15\n\ts_nop 7" ::: "memory");
        E(acc, cur, wr, wc, fr, fq);
        if (!has_next) break;
#pragma unroll
        for (int a = 0; a < 2; ++a)
#pragma unroll
            for (int b = 0; b < 2; ++b)
#pragma unroll
                for (int m = 0; m < 4; ++m)
#pragma unroll
                    for (int n = 0; n < 2; ++n) acc[a][b][m][n] = (f32x4){0.f, 0.f, 0.f, 0.f};
        cur = nxt; cA = nA; cB = nB; ++ui;
        if constexpr (GATHER) { _Pragma("unroll") for (int _i = 0; _i < 2; ++_i) { vA0[_i] = nA0[_i]; vA1[_i] = nA1[_i]; } }
        if (wr == 1) PG8_BAR;
    }
    PG8_WAIT_V(0);
    PG8_BAR;
#undef PG8_SA
#undef PG8_SB
#undef PG8_STAGE
#undef PG8_STGA
#undef PG8_ROWS
#undef PG8_LDA
#undef PG8_LDB
#undef PG8_MMA
#undef PG8_CAT8
#undef PG8_WAIT_V
#undef PG8_WAIT_L
#undef PG8_BAR
#undef PG8_SCHED
}
}

struct Args {
    const float* x; const int* positions; const float* norm1_g; const float* w_in;
    const float* lq1; const float* lk1; const float* lq2; const float* lk2;
    const float* diff_g; const float* ret_g; const float* w_o; const float* norm2_g;
    const float* w_router; const float* b_router; const float* w_moe_in; const float* b_moe_in;
    const float* w_moe_out; const float* b_moe_out; const float* norm_f_g;
    float* out; unsigned char* ws; int ph_lo, ph_hi;
};

#define KARGS const __attribute__((address_space(4))) Args&
typedef const __attribute__((address_space(4))) Args* KArgP;
__device__ __forceinline__ KArgP kargs() { KArgP p = (KArgP)__builtin_amdgcn_kernarg_segment_ptr(); asm volatile("" : "+s"(p)); return p; }
struct Frame {
    LAS unsigned char* lds;
    int tid, lane, wave, G, bid;
};

template <class RowMap>
__device__ __forceinline__ void transpose_item(const float* W, int K, int N, bf16_t* WT, LAS float* scr, int item, int lane, RowMap rowmap) {
    const int nblk = N / 32, kb = item / nblk, nb = item % nblk, k0 = 64 * kb, n0 = 32 * nb;
    float wv[32];
#pragma unroll
    for (int i = 0; i < 32; ++i) wv[i] = W[(size_t)(k0 + 2 * i + (lane >> 5)) * N + n0 + (lane & 31)];
#pragma unroll
    for (int i = 0; i < 32; ++i) scr[(2 * i + (lane >> 5)) * 33 + (lane & 31)] = wv[i];
    asm volatile("s_waitcnt lgkmcnt(0)" ::: "memory");
    const int c = lane & 7;
#pragma unroll
    for (int j = 0; j < 4; ++j) { const int n = (lane >> 3) + 8 * j; const LAS float* s = scr + (8 * c) * 33 + n;
        u32x4 o; o.x = pk2(s[0 * 33], s[1 * 33]); o.y = pk2(s[2 * 33], s[3 * 33]); o.z = pk2(s[4 * 33], s[5 * 33]); o.w = pk2(s[6 * 33], s[7 * 33]);
        *(u32x4*)(WT + (size_t)rowmap(n0 + n) * K + k0 + 8 * c) = o; }
    asm volatile("s_waitcnt lgkmcnt(0)" ::: "memory");
}
template <class RowMap>
__device__ __forceinline__ void transpose_item_fp8(const float* W, int K, int N, unsigned char* WT, LAS float* scr, int item, int lane, RowMap rowmap, float scale) {
    const int nblk = N / 32, kb = item / nblk, nb = item % nblk, k0 = 128 * kb, n0 = 32 * nb;
    { float wv[64];
#pragma unroll
      for (int i = 0; i < 64; ++i) wv[i] = __builtin_nontemporal_load(W + (size_t)(k0 + 2 * i + (lane >> 5)) * N + n0 + (lane & 31));
#pragma unroll
      for (int i = 0; i < 64; ++i) scr[(2 * i + (lane >> 5)) * 33 + (lane & 31)] = wv[i] * scale; }
    asm volatile("s_waitcnt lgkmcnt(0)" ::: "memory");
    const int c = lane & 7;
#pragma unroll
    for (int j = 0; j < 4; ++j) { const int n = (lane >> 3) + 8 * j; const LAS float* sp = scr + (16 * c) * 33 + n;
        u32x4 o; o.x = pk4_fp8(sp[0 * 33], sp[1 * 33], sp[2 * 33], sp[3 * 33]); o.y = pk4_fp8(sp[4 * 33], sp[5 * 33], sp[6 * 33], sp[7 * 33]);
        o.z = pk4_fp8(sp[8 * 33], sp[9 * 33], sp[10 * 33], sp[11 * 33]); o.w = pk4_fp8(sp[12 * 33], sp[13 * 33], sp[14 * 33], sp[15 * 33]);
        __builtin_nontemporal_store(o, (u32x4*)(WT + (size_t)rowmap(n0 + n) * K + k0 + 16 * c)); }
    asm volatile("s_waitcnt lgkmcnt(0)" ::: "memory");
}
__device__ __forceinline__ int win_rowmap(int n) {
    const bool isrope = (n < C_DV) || (n >= C_RQ && n < C_RV);
    if (!isrope) return n;
    const int d = n & 63, nn = d >> 5, i = d & 31;
    return (n & ~63) + 32 * (i >> 4) + 8 * ((i >> 2) & 3) + 4 * nn + (i & 3);
}
__device__ __forceinline__ int wmi_rowmap(int n) {
    const int t = n & 1, A = n >> 1;
    return 256 * (A >> 7) + 128 * t + (A & 127);
}
__device__ __forceinline__ int id_rowmap(int n) { return n; }

__device__ __forceinline__ void p0_prologue(const Frame& F, KARGS a, int parts = 7) {
    LAS float* scr = (LAS float*)(F.lds + F.wave * 16896);
    const int gw = F.bid * NWAVES + F.wave, NGW = F.G * NWAVES;
    bf16_t* Wt_in = (bf16_t*)(a.ws + WS_WIN); bf16_t* Wt_o = (bf16_t*)(a.ws + WS_WO); unsigned char* Wt_mi = a.ws + WS_WMI; unsigned char* Wt_mo = a.ws + WS_WMO;
    constexpr int I_IN = (DM / 64) * (PW / 32), I_O = (DM / 64) * (DM / 32), I_MI = (DM / 128) * (2 * FF / 32), I_MO = (FF / 128) * (DM / 32);
    constexpr int NITEMS = I_IN + I_O + NEXP * I_MI + NEXP * I_MO;
    if (parts & 1) for (int it = gw; it < NITEMS; it += NGW) {
        int r = it;
        if (r < I_IN) { transpose_item(a.w_in, DM, PW, Wt_in, scr, r, F.lane, win_rowmap); continue; } r -= I_IN;
        if (r < I_O) { transpose_item(a.w_o, DM, DM, Wt_o, scr, r, F.lane, id_rowmap); continue; } r -= I_O;
        if (r < NEXP * I_MI) { const int e = r / I_MI; transpose_item_fp8(a.w_moe_in + (size_t)e * DM * 2 * FF, DM, 2 * FF, Wt_mi + (size_t)e * 2 * FF * DM, scr, r % I_MI, F.lane, wmi_rowmap, W8_SCALE); continue; } r -= NEXP * I_MI;
        { const int e = r / I_MO; transpose_item_fp8(a.w_moe_out + (size_t)e * FF * DM, FF, DM, Wt_mo + (size_t)e * DM * FF, scr, r % I_MO, F.lane, id_rowmap, W8_SCALE); }
    }
    bf16_t* XN = (bf16_t*)(a.ws + WS_XN);
    if (parts & 2) { f32x4 g1[4];
#pragma unroll
      for (int j = 0; j < 4; ++j) g1[j] = *((const f32x4*)a.norm1_g + F.lane + 64 * j);
      for (int m0 = gw; m0 < NTOK; m0 += 2 * NGW) {
        const int m1 = (m0 + NGW < NTOK) ? m0 + NGW : m0;
        const f32x4* xa = (const f32x4*)(a.x + (size_t)m0 * DM) + F.lane; const f32x4* xb = (const f32x4*)(a.x + (size_t)m1 * DM) + F.lane;
        f32x4 va[4], vb[4]; float sa = 0.f, sb = 0.f;
#pragma unroll
        for (int j = 0; j < 4; ++j) { va[j] = __builtin_nontemporal_load(xa + 64 * j); vb[j] = __builtin_nontemporal_load(xb + 64 * j); }
#pragma unroll
        for (int j = 0; j < 4; ++j) { sa += (va[j].x * va[j].x + va[j].y * va[j].y) + (va[j].z * va[j].z + va[j].w * va[j].w); sb += (vb[j].x * vb[j].x + vb[j].y * vb[j].y) + (vb[j].z * vb[j].z + vb[j].w * vb[j].w); }
        const float ra = 1.0f / sqrtf(wave_sum(sa) * (1.0f / DM) + RMS_EPS), rb = 1.0f / sqrtf(wave_sum(sb) * (1.0f / DM) + RMS_EPS);
        unsigned long long* oa = (unsigned long long*)(XN + (size_t)m0 * DM) + F.lane; unsigned long long* ob = (unsigned long long*)(XN + (size_t)m1 * DM) + F.lane;
#pragma unroll
        for (int j = 0; j < 4; ++j) {
            oa[64 * j] = (unsigned long long)pk2(va[j].x * ra * g1[j].x, va[j].y * ra * g1[j].y) | ((unsigned long long)pk2(va[j].z * ra * g1[j].z, va[j].w * ra * g1[j].w) << 32);
            if (m1 != m0) ob[64 * j] = (unsigned long long)pk2(vb[j].x * rb * g1[j].x, vb[j].y * rb * g1[j].y) | ((unsigned long long)pk2(vb[j].z * rb * g1[j].z, vb[j].w * rb * g1[j].w) << 32); }
      } }
    float* rope = (float*)(a.ws + WS_ROPE);
    if (parts & 4) { const int i = F.lane & 31;
      const float inv_freq = 1.0f / powf(10000.0f, (float)(2 * i) / 64.0f);
      for (int m2 = gw; m2 < NTOK / 2; m2 += NGW) {
        const int row = 2 * m2 + (F.lane >> 5);
        const float ang = (float)a.positions[row] * inv_freq;
        const double q = (double)ang * 0.15915494309189535; const double r = ((double)ang - 6.283185307179586 * __builtin_rint(q));
        const float rf = (float)r;
        rope[(size_t)row * 64 + i] = __cosf(rf); rope[(size_t)row * 64 + 32 + i] = __sinf(rf);
      } }
}

__device__ __forceinline__ float ret_log2_gamma(int h) { return log2f(1.0f - exp2f(-5.0f - (float)h)); }
__device__ __forceinline__ void p2_ret_kv(const Frame& F, KARGS a) {
    const bf16_t* PROJ = (const bf16_t*)(a.ws + WS_PROJ); float* KVT = (float*)(a.ws + WS_KVT);
    LAS unsigned char* Kc = F.lds;
    LAS unsigned char* Vc = F.lds + 16384;
    const int lane = F.lane, w = F.wave, hi = lane >> 5;
    for (int u = F.bid; u < NB * 4 * NCH; u += F.G) {
        const int b = u / (4 * NCH), h = (u / NCH) & 3, n = u % NCH;
        const size_t row0 = (size_t)b * SEQ + (size_t)n * 128;
        const float lg = ret_log2_gamma(h);
        __syncthreads();
#pragma unroll
        for (int p = 0; p < 2; ++p) { const int idx = F.tid + p * NTHR, j = idx >> 3, c = idx & 7;
            u32x4 kv = *(const u32x4*)(PROJ + (row0 + j) * PW + C_RK + h * 64 + c * 8);
            const float dec = __builtin_amdgcn_exp2f(lg * (float)(127 - j));
            u32x4 o; o.x = pk2(bflo(kv.x) * dec, bfhi(kv.x) * dec); o.y = pk2(bflo(kv.y) * dec, bfhi(kv.y) * dec); o.z = pk2(bflo(kv.z) * dec, bfhi(kv.z) * dec); o.w = pk2(bflo(kv.w) * dec, bfhi(kv.w) * dec);
            *(LAS u32x4*)(Kc + j * 128 + c * 16) = o; }
#pragma unroll
        for (int p = 0; p < 4; ++p) { const int idx = F.tid + p * NTHR, j = idx >> 4, c = idx & 15;
            *(LAS u32x4*)(Vc + j * 256 + c * 16) = *(const u32x4*)(PROJ + (row0 + j) * PW + C_RV + h * 128 + c * 8); }
        __syncthreads();
        const int eb = w >> 1, db = w & 1;
        f32x16 acc = {};
        const int rsub = (lane & 15) >> 2, cb = 16 * ((lane >> 4) & 1) + 4 * (lane & 3);
#pragma unroll
        for (int s = 0; s < 8; ++s) {
            const int jlo = 16 * s + 4 * hi + rsub, jhi = jlo + 8;
            const bf16x8 af = cat8(tr_read(Vc + jlo * 256 + (32 * eb + cb) * 2), tr_read(Vc + jhi * 256 + (32 * eb + cb) * 2));
            const bf16x8 bfr = cat8(tr_read(Kc + jlo * 128 + (32 * db + cb) * 2), tr_read(Kc + jhi * 128 + (32 * db + cb) * 2));
            acc = MFMA32(af, bfr, acc);
        }
        float* o = KVT + (size_t)u * 8192;
#pragma unroll
        for (int r = 0; r < 16; ++r) o[(32 * eb + crow(r, hi)) * 64 + 32 * db + (lane & 31)] = acc[r];
    }
    { unsigned char* VT8 = a.ws + WS_VT8;
      const int dv = F.tid & 127, kq = F.tid >> 7, blk = kq >> 1, g0 = 2 * (kq & 1), fz = (dv >> 2) & 3;
      for (int u = F.bid; u < NB * 4 * (SEQ / 64); u += F.G) {
          const int bh = u >> 7, tt = u & 127, b = bh >> 2, h = bh & 3;
          const bf16_t* src = PROJ + ((size_t)b * SEQ + (size_t)tt * 64 + 32 * blk + 8 * g0) * PW + C_DV + h * 128 + dv;
          float v[16];
#pragma unroll
          for (int q = 0; q < 16; ++q) v[q] = bf2f(src[(size_t)q * PW]);
          unsigned char* row = VT8 + ((size_t)u * 128 + dv) * 64;
#pragma unroll
          for (int hh = 0; hh < 2; ++hh) { u32x2 w; w.x = pk4_fp8(v[4 * hh], v[4 * hh + 1], v[4 * hh + 2], v[4 * hh + 3]); w.y = pk4_fp8(v[8 + 4 * hh], v[8 + 4 * hh + 1], v[8 + 4 * hh + 2], v[8 + 4 * hh + 3]);
              *(u32x2*)(row + (((2 * hh + blk) ^ fz) << 4) + 4 * g0) = w; }
      } }
}
__device__ __forceinline__ void p3_ret_scan(const Frame& F, KARGS a) {
    const float* __restrict__ KVT = (const float*)(a.ws + WS_KVT); bf16_t* __restrict__ PREVT = (bf16_t*)(a.ws + WS_PREVT);
    for (int g = F.bid * NTHR + F.tid; g < NB * 4 * 8192; g += F.G * NTHR) {
        const int bh = g >> 13, ed = g & 8191, h = bh & 3;
        const float cd = exp2f(ret_log2_gamma(h) * 128.0f);
        float st = 0.f;
        for (int n0 = 0; n0 < NCH; n0 += 16) {
            float kv[16];
#pragma unroll
            for (int q = 0; q < 16; ++q) kv[q] = KVT[((size_t)(bh * NCH + n0 + q) << 13) + ed];
#pragma unroll
            for (int q = 0; q < 16; ++q) { PREVT[((size_t)(bh * NCH + n0 + q) << 13) + ed] = (bf16_t)f2bf(st); st = st * cd + kv[q]; }
        }
    }
}

__device__ __forceinline__ unsigned cvtpk(float lo, float hi) { typedef __bf16 bf16x2_t __attribute__((ext_vector_type(2))); f32x2 v = {lo, hi}; bf16x2_t b = __builtin_convertvector(v, bf16x2_t); return __builtin_bit_cast(unsigned, b); }
__device__ __forceinline__ bf16x8 packp(const f32x16& p, int b) {
    u32x4 w; w.x = cvtpk(p[b], p[b + 1]); w.y = cvtpk(p[b + 2], p[b + 3]); w.z = cvtpk(p[b + 4], p[b + 5]); w.w = cvtpk(p[b + 6], p[b + 7]);
    return __builtin_bit_cast(bf16x8, w);
}
__device__ __forceinline__ float halfmax(float m) { auto rr = __builtin_amdgcn_permlane32_swap(__float_as_uint(m), __float_as_uint(m), false, false); return fmaxf(__uint_as_float(rr[0]), __uint_as_float(rr[1])); }
__device__ __forceinline__ float halfsum(float m) { auto rr = __builtin_amdgcn_permlane32_swap(__float_as_uint(m), __float_as_uint(m), false, false); return __uint_as_float(rr[0]) + __uint_as_float(rr[1]); }
__device__ __forceinline__ void glds16(const void* gsrc, unsigned lds_dst) { unsigned keep;
    asm volatile("s_mov_b32 %0, m0\n\ts_mov_b32 m0, %2\n\ts_nop 0\n\tglobal_load_lds_dwordx4 %1, off\n\ts_mov_b32 m0, %0" : "=&s"(keep) : "v"(gsrc), "s"(lds_dst) : "memory"); }
__device__ __forceinline__ float max3f(float a, float b, float c) { return fmaxf(fmaxf(a, b), c); }
__device__ __forceinline__ float fadd_s(float a, float b) { return a + b; }
constexpr float ATT_THR = 8.0f;
__device__ __forceinline__ void attn_unit(const Frame& F, KARGS a, int b, int h, int qb, float lam) {
    const bf16_t* PROJ = (const bf16_t*)(a.ws + WS_PROJ); bf16_t* MIX = (bf16_t*)(a.ws + WS_MIX);
    const int lane = F.lane, w = F.wave, hi = lane >> 5, r32 = lane & 31, br = w >> 2, ib = w & 3;
    const size_t rowb = (size_t)b * SEQ;
    const int q0 = qb * 128 + ib * 32;
    const int NT = 2 * qb + 2;
    const int ntw = 2 * qb + (ib >= 2 ? 2 : 1);
    LAS unsigned char* qfl = F.lds + 114688 + w * 4096 + lane * 16;
    __syncthreads();
    f32x16 o[4]; o[0] = f32x16{}; o[1] = f32x16{}; o[2] = f32x16{}; o[3] = f32x16{};
    float mrun = 0.f;
    f32x16 Lacc = f32x16{};
    v8i ones8; { _Pragma("unroll") for (int q_ = 0; q_ < 8; ++q_) ones8[q_] = 0x38383838; asm volatile("" : "+v"(ones8)); }
    bool refzero = true;
    const bf16_t* kg0 = PROJ + (rowb + (w & 3) * 16 + (lane >> 2)) * PW + C_DK + h * 128 + ((w >> 2) * 4 + ((lane & 3) ^ ((lane >> 4) & 3))) * 8;
    const unsigned char* vg0 = a.ws + WS_VT8 + (size_t)(b * 4 + h) * 128 * 8192 + w * 1024 + lane * 16;
    const unsigned lds0 = (unsigned)(uintptr_t)F.lds + (unsigned)w * 1024u;
#define AT_STAGE_K(t, ks) do { const size_t ro_ = (size_t)((t) < NT ? (t) : NT - 1) * 64 * PW; const unsigned sb_ = (unsigned)__builtin_amdgcn_readfirstlane((int)(lds0 + (unsigned)(ks) * 16384u)); \
        glds16(kg0 + ro_, sb_); glds16(kg0 + ro_ + 64, sb_ + 8192u); } while (0)
#define AT_STAGE_V(t, vs) do { const size_t ro_ = (size_t)((t) < NT ? (t) : NT - 1) * 8192; const unsigned sb_ = (unsigned)__builtin_amdgcn_readfirstlane((int)(lds0 + 49152u + (unsigned)(vs) * 8192u)); \
        glds16(vg0 + ro_, sb_); } while (0)
#define AT_KOFF(d0) ((((2 * br + ((d0) >> 1)) * 4 + (r32 >> 4)) * 1024) + ((r32 & 15) * 4 + ((2 * ((d0) & 1) + hi) ^ ((r32 >> 2) & 3))) * 16)
#define AT_QK_BODY(dst0, dst1, ks, cinit) do { const LAS unsigned char* kp_ = F.lds + (ks) * 16384; \
        bf16x8 ka_ = *(const LAS bf16x8*)(kp_ + AT_KOFF(0)), kb_ = *(const LAS bf16x8*)(kp_ + AT_KOFF(0) + 2048), qa_ = *(const LAS bf16x8*)(qfl); \
        __builtin_amdgcn_s_setprio(1); \
        _Pragma("unroll") for (int d0 = 0; d0 < 4; ++d0) { bf16x8 kc_ = ka_, kd_ = kb_, qc_ = qa_; \
            if (d0 < 3) { ka_ = *(const LAS bf16x8*)(kp_ + AT_KOFF(d0 + 1)); kb_ = *(const LAS bf16x8*)(kp_ + AT_KOFF(d0 + 1) + 2048); qa_ = *(const LAS bf16x8*)(qfl + (d0 + 1) * 1024); } \
            if (d0 == 0) { dst0 = MFMA32(kc_, qc_, cinit); dst1 = MFMA32(kd_, qc_, cinit); } else { dst0 = MFMA32(kc_, qc_, dst0); dst1 = MFMA32(kd_, qc_, dst1); } } \
        __builtin_amdgcn_s_setprio(0); } while (0)
#define AT_QK(dst0, dst1, ks) do { if (refzero) { const f32x16 z_ = f32x16{}; AT_QK_BODY(dst0, dst1, ks, z_); } \
        else { f32x16 nm_; _Pragma("unroll") for (int r = 0; r < 16; ++r) nm_[r] = -mrun; AT_QK_BODY(dst0, dst1, ks, nm_); } } while (0)
#define AT_BAR(n) do { asm volatile("s_waitcnt vmcnt(" #n ") lgkmcnt(0)" ::: "memory"); __builtin_amdgcn_s_barrier(); asm volatile("" ::: "memory"); } while (0)
#define AT_SOFTMAX(C0, C1, t, PF) do { \
        if ((t) == ntw - 1) { const int qi = q0 + r32 - (t) * 64; \
            _Pragma("unroll") for (int r = 0; r < 16; ++r) { const int kv = crow(r, hi); if (kv > qi) C0[r] = -INFINITY; if (kv + 32 > qi) C1[r] = -INFINITY; } } \
        float mx; { float a_ = max3f(C0[0], C0[1], C1[0]), b_ = max3f(C0[2], C0[3], C1[1]); a_ = max3f(a_, C1[2], C1[3]); \
            _Pragma("unroll") for (int r = 4; r < 16; r += 4) { a_ = max3f(a_, C0[r], C0[r + 1]); b_ = max3f(b_, C0[r + 2], C0[r + 3]); a_ = max3f(a_, C1[r], C1[r + 1]); b_ = max3f(b_, C1[r + 2], C1[r + 3]); } \
            mx = halfmax(fmaxf(a_, b_)); } \
          \
        if (__any(mx > ATT_THR) || ((t) == 0 && __any(mx < -ATT_THR))) { \
            const float dl = ((t) == 0) ? mx : fmaxf(mx, 0.f); mrun += dl; const float f = __builtin_amdgcn_exp2f(-dl); refzero = false; \
            asm volatile("s_nop 15\n\ts_nop 7" : "+v"(o[0]), "+v"(o[1]), "+v"(o[2]), "+v"(o[3]), "+v"(Lacc));        \
            _Pragma("unroll") for (int d = 0; d < 4; ++d) _Pragma("unroll") for (int r = 0; r < 16; ++r) o[d][r] *= f; \
            _Pragma("unroll") for (int r = 0; r < 16; ++r) Lacc[r] *= f; \
            _Pragma("unroll") for (int r = 0; r < 16; ++r) { C0[r] -= dl; C1[r] -= dl; } } \
        _Pragma("unroll") for (int r = 0; r < 16; ++r) { C0[r] = __builtin_amdgcn_exp2f(C0[r]); C1[r] = __builtin_amdgcn_exp2f(C1[r]); } \
        PF[0] = (int)pk4_fp8(C0[0], C0[1], C0[2], C0[3]); PF[1] = (int)pk4_fp8(C0[4], C0[5], C0[6], C0[7]); PF[2] = (int)pk4_fp8(C0[8], C0[9], C0[10], C0[11]); PF[3] = (int)pk4_fp8(C0[12], C0[13], C0[14], C0[15]); \
        PF[4] = (int)pk4_fp8(C1[0], C1[1], C1[2], C1[3]); PF[5] = (int)pk4_fp8(C1[4], C1[5], C1[6], C1[7]); PF[6] = (int)pk4_fp8(C1[8], C1[9], C1[10], C1[11]); PF[7] = (int)pk4_fp8(C1[12], C1[13], C1[14], C1[15]); } while (0)
    const int mx1_ = 0x7f7f7f7f;
#define AT_PV(vs, PF) do { \
        const LAS unsigned char* vp = F.lds + 49152 + (vs) * 8192 + r32 * 64; const int s0_ = ((2 * hi) ^ ((r32 >> 2) & 3)) << 4, s1_ = ((2 * hi + 1) ^ ((r32 >> 2) & 3)) << 4; \
        v8i va_[2]; \
        va_[0] = __builtin_bit_cast(v8i, __builtin_shufflevector(*(const LAS u32x4*)(vp + s0_), *(const LAS u32x4*)(vp + s1_), 0, 1, 2, 3, 4, 5, 6, 7)); \
        _Pragma("unroll") for (int d = 0; d < 4; ++d) { \
            if (d < 3) va_[(d + 1) & 1] = __builtin_bit_cast(v8i, __builtin_shufflevector(*(const LAS u32x4*)(vp + (d + 1) * 2048 + s0_), *(const LAS u32x4*)(vp + (d + 1) * 2048 + s1_), 0, 1, 2, 3, 4, 5, 6, 7)); \
            asm volatile("s_nop 3\n\tv_mfma_scale_f32_32x32x64_f8f6f4 %0, %1, %2, %0, %3, %3 op_sel_hi:[0,0,0]" : "+v"(o[d]) : "v"(va_[d & 1]), "v"(PF), "v"(mx1_)); } \
          \
        asm volatile("v_mfma_scale_f32_32x32x64_f8f6f4 %0, %1, %2, %0, %3, %3 op_sel_hi:[0,0,0]" : "+v"(Lacc) : "v"(ones8), "v"(PF), "v"(mx1_)); \
        } while (0)
    AT_STAGE_K(0, 0); AT_STAGE_V(0, 0);
    AT_STAGE_K(1, 1); AT_STAGE_V(1, 1);
    { const bf16_t* qp = PROJ + (rowb + q0 + r32) * PW + C_DQ + h * 128 + br * 64 + hi * 8;
#pragma unroll
      for (int d0 = 0; d0 < 4; ++d0) *(LAS bf16x8*)(qfl + d0 * 1024) = *(const bf16x8*)(qp + d0 * 16); }
    AT_BAR(3);
    f32x16 sc0, sc1;
    v8i pfb;
    int kcur = 0;
#define AT_STEP(t) do { \
        { const int kst = kcur == 0 ? 2 : kcur - 1; AT_STAGE_K((t) + 2, kst); AT_STAGE_V((t) + 2, ((t) + 2) & 3); }        \
          \
        if (br == 1 && (t) >= 1 && (t) - 1 < ntw) AT_PV(((t) - 1) & 3, pfb); \
        if ((t) < ntw) { AT_QK(sc0, sc1, kcur); AT_SOFTMAX(sc0, sc1, t, pfb); } \
        if (br == 0 && (t) < ntw) AT_PV((t) & 3, pfb); \
        AT_BAR(3); \
        kcur = kcur == 2 ? 0 : kcur + 1; } while (0)
    for (int t = 0; t < NT; ++t) AT_STEP(t);
    if (br == 1 && ntw == NT) AT_PV((NT - 1) & 3, pfb);
#undef AT_STEP
#undef AT_SOFTMAX
#undef AT_PV
    asm volatile("s_waitcnt vmcnt(0) lgkmcnt(0)" ::: "memory");
    __syncthreads();
#undef AT_STAGE_K
#undef AT_STAGE_V
#undef AT_QK
#undef AT_QK_BODY
#undef AT_KOFF
#undef AT_BAR
    asm volatile("s_nop 15\n\ts_nop 7" : "+v"(o[0]), "+v"(o[1]), "+v"(o[2]), "+v"(o[3]), "+v"(Lacc));
    const float il = 1.0f / Lacc[0];
    LAS float* cmb = (LAS float*)F.lds + ib * 4096;
    if (br == 1) {
#pragma unroll
        for (int d = 0; d < 4; ++d)
#pragma unroll
            for (int r = 0; r < 16; ++r) cmb[(32 * d + crow(r, hi)) * 32 + r32] = o[d][r] * il;
    }
    __syncthreads();
    if (br == 0) {
        float ss = 0.f;
#pragma unroll
        for (int d = 0; d < 4; ++d)
#pragma unroll
            for (int r = 0; r < 16; ++r) { const float v = o[d][r] * il - lam * cmb[(32 * d + crow(r, hi)) * 32 + r32]; o[d][r] = v; ss += v * v; }
        ss = halfsum(ss);
        const float rn = 0.8f / sqrtf(ss * (1.0f / 128.0f) + RMS_EPS);
        LAS bf16_t* stg = (LAS bf16_t*)(F.lds + 65536) + ib * 4096;
#pragma unroll
        for (int d = 0; d < 4; ++d)
#pragma unroll
            for (int r = 0; r < 16; ++r) { const int dv = 32 * d + crow(r, hi); stg[r32 * 128 + dv] = (bf16_t)f2bf(o[d][r] * rn * a.diff_g[dv]); }
        asm volatile("s_waitcnt lgkmcnt(0)" ::: "memory");
#pragma unroll
        for (int i = 0; i < 8; ++i) { const int row = i * 4 + (lane >> 4), ch = lane & 15;
            *(u32x4*)(MIX + (rowb + q0 + row) * DM + h * 128 + ch * 8) = *(const LAS u32x4*)(stg + row * 128 + ch * 8); }
    }
}
__device__ __forceinline__ void ret_unit(const Frame& F, KARGS a, int item0) {
    const bf16_t* PROJ = (const bf16_t*)(a.ws + WS_PROJ); bf16_t* MIX = (bf16_t*)(a.ws + WS_MIX); const bf16_t* PREVT = (const bf16_t*)(a.ws + WS_PREVT);
    const int lane = F.lane, w = F.wave, hi = lane >> 5, r32 = lane & 31, q4 = w >> 2, ib = w & 3;
    const int item = item0 + q4;
    const int b = item / (4 * NCH), h = (item / NCH) & 3, n = item % NCH;
    const size_t row0 = (size_t)b * SEQ + (size_t)n * 128;
    const float lg = ret_log2_gamma(h);
    LAS unsigned char* Kb = F.lds + q4 * 49152;
    LAS unsigned char* Vb = Kb + 16384;
    const int t4 = F.tid & 255;
    __syncthreads();
#pragma unroll
    for (int p = 0; p < 4; ++p) { const int idx = t4 + p * 256, c = idx >> 7, key = idx & 127;
        *(LAS u32x4*)(Kb + idx * 16) = *(const u32x4*)(PROJ + (row0 + key) * PW + C_RK + h * 64 + c * 8); }
#pragma unroll
    for (int p = 0; p < 8; ++p) { const int idx = t4 + p * 256, j = idx >> 4, c = idx & 15;
        *(LAS u32x4*)(Vb + j * 256 + c * 16) = *(const u32x4*)(PROJ + (row0 + j) * PW + C_RV + h * 128 + c * 8); }
    bf16x8 qf[4];
    { const bf16_t* qp = PROJ + (row0 + ib * 32 + r32) * PW + C_RQ + h * 64 + hi * 8;
#pragma unroll
      for (int d0 = 0; d0 < 4; ++d0) qf[d0] = *(const bf16x8*)(qp + d0 * 16); }
    f32x16 acc[4];
    { const bf16_t* pp = PREVT + (size_t)item * 8192 + (size_t)r32 * 64 + hi * 8;
#pragma unroll
      for (int eb = 0; eb < 4; ++eb) { acc[eb] = f32x16{};
#pragma unroll
          for (int s = 0; s < 4; ++s) { const bf16x8 af = *(const bf16x8*)(pp + eb * 32 * 64 + s * 16); acc[eb] = MFMA32(af, qf[s], acc[eb]); } } }
    const int i = ib * 32 + r32;
    { const float qd = exp2f(lg * (float)(i + 1));
#pragma unroll
      for (int eb = 0; eb < 4; ++eb)
#pragma unroll
          for (int r = 0; r < 16; ++r) acc[eb][r] *= qd; }
    __syncthreads();
    const int rsub = (lane & 15) >> 2, cb = 16 * ((lane >> 4) & 1) + 4 * (lane & 3);
    for (int jb = 0; jb <= ib; ++jb) {
        f32x16 s0 = {};
        const LAS unsigned char* kp = Kb + hi * 2048 + (jb * 32 + r32) * 16;
#pragma unroll
        for (int d0 = 0; d0 < 4; ++d0) { const bf16x8 kf = *(const LAS bf16x8*)(kp + d0 * 4096); s0 = MFMA32(kf, qf[d0], s0); }
#pragma unroll
        for (int r = 0; r < 16; ++r) { const int j = jb * 32 + crow(r, hi); s0[r] = (i >= j) ? s0[r] * exp2f(lg * (float)(i - j)) : 0.f; }
        bf16x8 pf[2]; pf[0] = pack8(s0, 0); pf[1] = pack8(s0, 8);
#pragma unroll
        for (int eb = 0; eb < 4; ++eb)
#pragma unroll
            for (int s = 0; s < 2; ++s) {
                const int jlo = jb * 32 + 16 * s + 4 * hi + rsub, jhi = jlo + 8;
                const bf16x8 vf = cat8(tr_read(Vb + jlo * 256 + (32 * eb + cb) * 2), tr_read(Vb + jhi * 256 + (32 * eb + cb) * 2));
                acc[eb] = MFMA32(vf, pf[s], acc[eb]);
            }
    }
    float ss = 0.f;
#pragma unroll
    for (int eb = 0; eb < 4; ++eb)
#pragma unroll
        for (int r = 0; r < 16; ++r) ss += acc[eb][r] * acc[eb][r];
    ss += __shfl_xor(ss, 32);
    const float rn = 1.0f / sqrtf(ss * (1.0f / 128.0f) + RMS_EPS);
    const bf16_t* gp = PROJ + (row0 + i) * PW + C_RG + h * 128;
    bf16_t* op = MIX + (row0 + i) * DM + 512 + h * 128;
#pragma unroll
    for (int eb = 0; eb < 4; ++eb)
#pragma unroll
        for (int r = 0; r < 16; ++r) { const int e = 32 * eb + crow(r, hi);
            const float g = bf2f(gp[e]); const float sg = g / (1.0f + exp2f(-LOG2E * g));
            op[e] = (bf16_t)f2bf(acc[eb][r] * rn * a.ret_g[h * 128 + e] * sg); }
}
__device__ __forceinline__ void p4_mixers(const Frame& F, KARGS a) {
    float lam;
    { const float p1 = a.lq1[F.lane] * a.lk1[F.lane], p2 = a.lq2[F.lane] * a.lk2[F.lane];
      lam = expf(wave_sum(p1)) - expf(wave_sum(p2)) + 0.2f; }
    const int NU = NB * 4 * 64;
    for (int L0 = F.bid, round0 = 0; L0 < NU * (((DOUBLE_MASK >> 4) & 1) + 1); L0 += F.G, ++round0) {
        const int L = L0 >= NU ? L0 - NU : L0, round = round0 & 3;
        int rank = L >> 4; const int bh = L & 15;
        int qb = 63 - rank;
        if (F.G == 256 && (round & 1)) { const int lo = (round * 256) >> 4, hi_ = lo + 15; qb = 63 - (lo + hi_ - rank); }
        attn_unit(F, a, bh >> 2, bh & 3, qb, lam);
    }
    for (int u0 = F.bid; u0 < (NB * 4 * NCH / 2) * (((DOUBLE_MASK >> 11) & 1) + 1); u0 += F.G) ret_unit(F, a, 2 * (u0 >= (NB * 4 * NCH / 2) ? u0 - (NB * 4 * NCH / 2) : u0));
}

constexpr int WR_ROWB = 2080;
constexpr int LDS_WRL = 32 * WR_ROWB;
constexpr int LDS_LCNT = 2 * 32 * WR_ROWB;
constexpr int LDS_LGS = LDS_LCNT + 256;
constexpr int LDS_TOP = LDS_LGS + 8 * 2048;
__device__ __forceinline__ void p6_router(const Frame& F, KARGS a) {
    const bf16_t* X1 = (const bf16_t*)(a.ws + WS_X1B); unsigned* TK = (unsigned*)(a.ws + WS_TOPK);
    const int lane = F.lane;
    for (int idx = F.tid; idx < DM * NEXP; idx += NTHR) { const int k = idx >> 5, e = idx & 31;
        const float v = a.w_router[idx] * a.norm2_g[k]; const unsigned h = f2bf(v); const float hf = __builtin_bit_cast(float, h << 16);
        *(LAS bf16_t*)(F.lds + e * WR_ROWB + k * 2) = (bf16_t)h; *(LAS bf16_t*)(F.lds + LDS_WRL + e * WR_ROWB + k * 2) = (bf16_t)f2bf(v - hf); }
    LAS unsigned* lcnt = (LAS unsigned*)(F.lds + LDS_LCNT);
    if (F.tid < 32) lcnt[F.tid] = 0u;
    __syncthreads();
    const int t16 = lane & 15, kb = lane >> 4;
    LAS float* lgs = (LAS float*)(F.lds + LDS_LGS) + F.wave * 512;
    LAS float* tops = (LAS float*)(F.lds + LDS_TOP) + F.wave * 64;
    const int RPW = (NTOK + F.G - 1) / F.G;
    for (int rb = F.wave * 16; rb < RPW; rb += NWAVES * 16) {
        const int m0 = F.bid * RPW + rb;
        if (m0 >= NTOK) break;
        const int mrow = (m0 + t16 < NTOK && rb + t16 < RPW) ? m0 + t16 : m0;
        const bf16_t* xr = X1 + (size_t)mrow * DM + 8 * kb;
        f32x4 acc0 = {0.f, 0.f, 0.f, 0.f}, acc1 = {0.f, 0.f, 0.f, 0.f}; float ss = 0.f;
        const LAS unsigned char* wp = F.lds + t16 * WR_ROWB + kb * 16;
#pragma unroll 4
        for (int s = 0; s < 32; ++s) {
            const u32x4 xw = *(const u32x4*)(xr + 32 * s);
            { const float a0 = bflo(xw.x), a1 = bfhi(xw.x), a2 = bflo(xw.y), a3 = bfhi(xw.y), a4 = bflo(xw.z), a5 = bfhi(xw.z), a6 = bflo(xw.w), a7 = bfhi(xw.w);
              ss += (a0 * a0 + a1 * a1) + (a2 * a2 + a3 * a3) + (a4 * a4 + a5 * a5) + (a6 * a6 + a7 * a7); }
            const bf16x8 xh = __builtin_bit_cast(bf16x8, xw);
            const bf16x8 wh0 = *(const LAS bf16x8*)(wp + s * 64), wl0 = *(const LAS bf16x8*)(wp + LDS_WRL + s * 64);
            const bf16x8 wh1 = *(const LAS bf16x8*)(wp + 16 * WR_ROWB + s * 64), wl1 = *(const LAS bf16x8*)(wp + LDS_WRL + 16 * WR_ROWB + s * 64);
            acc0 = __builtin_amdgcn_mfma_f32_16x16x32_bf16(wh0, xh, acc0, 0, 0, 0); acc1 = __builtin_amdgcn_mfma_f32_16x16x32_bf16(wh1, xh, acc1, 0, 0, 0);
            acc0 = __builtin_amdgcn_mfma_f32_16x16x32_bf16(wl0, xh, acc0, 0, 0, 0); acc1 = __builtin_amdgcn_mfma_f32_16x16x32_bf16(wl1, xh, acc1, 0, 0, 0);
        }
        ss += __shfl_xor(ss, 16); ss += __shfl_xor(ss, 32);
        const float r2 = 1.0f / sqrtf(ss * (1.0f / DM) + RMS_EPS);
        float val[8];
        { const f32x4 b0 = *(const f32x4*)(a.b_router + 4 * kb), b1 = *(const f32x4*)(a.b_router + 16 + 4 * kb);
#pragma unroll
          for (int jx = 0; jx < 4; ++jx) { val[jx] = acc0[jx] * r2 + b0[jx]; val[4 + jx] = acc1[jx] * r2 + b1[jx]; } }
        *(LAS f32x4*)(lgs + t16 * 32 + 4 * kb) = (f32x4){val[0], val[1], val[2], val[3]};
        *(LAS f32x4*)(lgs + t16 * 32 + 16 + 4 * kb) = (f32x4){val[4], val[5], val[6], val[7]};
        asm volatile("s_waitcnt lgkmcnt(0)" ::: "memory");
        int rank[8];
#pragma unroll
        for (int i = 0; i < 8; ++i) rank[i] = 0;
#pragma unroll
        for (int e4 = 0; e4 < 8; ++e4) { const f32x4 o = *(const LAS f32x4*)(lgs + t16 * 32 + 4 * e4);
#pragma unroll
            for (int c = 0; c < 4; ++c) { const int oe = 4 * e4 + c;
#pragma unroll
                for (int i = 0; i < 8; ++i) { const int me = 16 * (i >> 2) + 4 * kb + (i & 3); rank[i] += (o[c] > val[i] || (o[c] == val[i] && oe < me)) ? 1 : 0; } } }
#pragma unroll
        for (int i = 0; i < 8; ++i) if (rank[i] < 4) tops[t16 * 4 + rank[i]] = val[i];
        asm volatile("s_waitcnt lgkmcnt(0)" ::: "memory");
        const f32x4 tv = *(const LAS f32x4*)(tops + t16 * 4);
        const float e1 = expf(tv[1] - tv[0]), e2 = expf(tv[2] - tv[0]), e3 = expf(tv[3] - tv[0]);
        const float inv = 1.0f / (1.0f + e1 + e2 + e3);
        const bool rowok = (m0 + t16 < NTOK) && (rb + t16 < RPW);
        if (rowok) { unsigned* trow = TK + (size_t)(m0 + t16) * 16;
#pragma unroll
            for (int i = 0; i < 8; ++i) if (rank[i] < 4) { const int me = 16 * (i >> 2) + 4 * kb + (i & 3); const int rk = rank[i];
                const float gt = (rk == 0 ? 1.0f : rk == 1 ? e1 : rk == 2 ? e2 : e3) * inv;
                const unsigned slot = __hip_atomic_fetch_add(lcnt + me, 1u, __ATOMIC_RELAXED, __HIP_MEMORY_SCOPE_WORKGROUP);
                trow[rk] = (unsigned)me; trow[4 + rk] = __builtin_bit_cast(unsigned, gt); trow[8 + rk] = slot; }
            if (kb == 0) trow[12] = __builtin_bit_cast(unsigned, r2); }
        for (int i = 0; i < 16; ++i) { const int m = m0 + i; if (m >= NTOK || rb + i >= RPW) break;
            const float r2i = __shfl(r2, i);
            const u32x2* x4 = (const u32x2*)(X1 + (size_t)m * DM) + lane; unsigned* h2 = (unsigned*)(a.ws + WS_H2 + (size_t)m * DM) + lane;
#pragma unroll
            for (int jx = 0; jx < 4; ++jx) { const u32x2 v = x4[64 * jx]; const f32x4 g = *((const f32x4*)a.norm2_g + lane + 64 * jx);
                h2[64 * jx] = pk4_fp8(bflo(v.x) * r2i * g.x, bfhi(v.x) * r2i * g.y, bflo(v.y) * r2i * g.z, bfhi(v.y) * r2i * g.w); } }
    }
    __syncthreads();
    { int t2 = threadIdx.x; asm volatile("" : "+v"(t2));
      if (t2 < 32) ((unsigned*)(a.ws + WS_HIST))[F.bid * 32 + t2] = lcnt[t2]; }
}
__device__ __forceinline__ unsigned expert_offsets(const unsigned* ctl, int lane, unsigned& ntiles) {
    const unsigned c = (lane < 32) ? __hip_atomic_load(ctl + CW_CNT + (lane & 31), __ATOMIC_RELAXED, __HIP_MEMORY_SCOPE_AGENT) : 0u;
    const unsigned t = (c + 255u) >> 8;
    unsigned inc = t;
#pragma unroll
    for (int o = 1; o < 32; o <<= 1) { const unsigned v = __shfl_up(inc, o); if ((lane & 31) >= o) inc += v; }
    ntiles = __shfl(inc, 31);
    return (inc - t) << 8;
}
__device__ __forceinline__ void p7_scatter(const Frame& F, KARGS a) {
    unsigned* TK = (unsigned*)(a.ws + WS_TOPK); unsigned* RL = (unsigned*)(a.ws + WS_ROWLIST);
    const int lane = F.lane;
    LAS unsigned* red = (LAS unsigned*)(F.lds);
    { const unsigned* hist = (const unsigned*)(a.ws + WS_HIST);
      const int e = F.tid & 31, part = F.tid >> 5, per = (F.G + 15) / 16;
      unsigned sa = 0, sb = 0;
      for (int wg = part * per; wg < (part + 1) * per && wg < F.G; ++wg) { const unsigned c = hist[wg * 32 + e]; sa += c; if (wg < F.bid) sb += c; }
      red[part * 32 + e] = sa; red[512 + part * 32 + e] = sb; }
    __syncthreads();
    if (F.tid < 64) {
        unsigned tot = 0, base = 0;
        if (lane < 32) for (int p = 0; p < 16; ++p) { tot += red[p * 32 + lane]; base += red[512 + p * 32 + lane]; }
        const unsigned tl = (tot + 255u) >> 8; unsigned inc = tl;
#pragma unroll
        for (int o = 1; o < 32; o <<= 1) { const unsigned v = __shfl_up(inc, o); if ((lane & 31) >= o) inc += v; }
        if (lane < 32) { red[1024 + lane] = ((inc - tl) << 8) + base; red[1056 + lane] = (inc - tl) << 8; red[1088 + lane] = tot; if (F.bid == 0) ((unsigned*)(a.ws + WS_CTL))[CW_CNT + lane] = tot; }
    }
    __syncthreads();
    if (F.bid < NEXP) { const unsigned st = red[1056 + F.bid] + red[1088 + F.bid], en = red[1056 + F.bid] + (((red[1088 + F.bid] + 255u) >> 8) << 8);
        for (unsigned p = st + F.tid; p < en; p += NTHR) RL[p] = 0u; }
    const unsigned myoff = red[1024 + (lane & 31)];
    const int RPW = (NTOK + F.G - 1) / F.G, RPV = (RPW + NWAVES - 1) / NWAVES;
    for (int i = 0; i < RPV; ++i) {
        const int ml = F.wave * RPV + i, m = F.bid * RPW + ml;
        if (ml >= RPW || m >= NTOK) break;
        unsigned* t = TK + (size_t)m * 16;
        unsigned e = 0, sl = 0;
        if (lane < 4) { e = t[lane]; sl = t[8 + lane]; }
        const unsigned pos = __shfl(myoff, (int)e) + sl;
        if (lane < 4) { RL[pos] = (unsigned)m; t[8 + lane] = pos; }
    }
}
__device__ __forceinline__ int build_tile_table(const Frame& F, KARGS a) {
    const unsigned* ctl = (const unsigned*)(a.ws + WS_CTL);
    unsigned ntiles; const unsigned myoff = expert_offsets(ctl, F.lane, ntiles);
    LAS unsigned char* tab = F.lds + LDS_MISC;
    const unsigned nextoff = __shfl_down(myoff, 1);
    __syncthreads();
    if (F.wave == 0 && F.lane < 32) {
        const unsigned t0 = myoff >> 8, t1 = (F.lane == 31) ? ntiles : (nextoff >> 8);
        for (unsigned t = t0; t < t1; ++t) tab[t] = (unsigned char)F.lane;
    }
    __syncthreads();
    return __builtin_amdgcn_readfirstlane((int)ntiles);
}
template <class Sched>
__device__ __forceinline__ void build_row_table(const Frame& F, KARGS a, const Sched& S) {
    const unsigned* RL = (const unsigned*)(a.ws + WS_ROWLIST);
    LAS unsigned* rtab = (LAS unsigned*)(F.lds + LDS_ROWTAB);
    pg8::Unit u;
    for (int ui = 0; ui < ROWTAB_UNITS && S.next(ui, u); ++ui)
        if (F.tid < 256) rtab[ui * 256 + F.tid] = RL[(size_t)u.pm * 256 + F.tid] << 10;
    __syncthreads();
}
__device__ __forceinline__ void p10_final(const Frame& F, KARGS a) {
    const bf16_t* X1 = (const bf16_t*)(a.ws + WS_X1B); float* OUT = a.out; const unsigned* TK = (const unsigned*)(a.ws + WS_TOPK); const unsigned char* Y = a.ws + WS_Y;
    const int gw = F.bid * NWAVES + F.wave, NGW = F.G * NWAVES, lane = F.lane;
    f32x4 gf[4];
#pragma unroll
    for (int j = 0; j < 4; ++j) gf[j] = *((const f32x4*)a.norm_f_g + lane + 64 * j);
    for (int m0 = gw; m0 < NTOK; m0 += 2 * NGW) {
        const int m1 = m0 + NGW; const bool two = m1 < NTOK; const int mb = two ? m1 : m0;
        const unsigned* t0 = TK + (size_t)m0 * 16; const unsigned* t1 = TK + (size_t)mb * 16;
        float g0[4], g1[4]; unsigned p0[4], p1[4];
#pragma unroll
        for (int k = 0; k < 4; ++k) { g0[k] = __builtin_bit_cast(float, t0[4 + k]); p0[k] = t0[8 + k]; g1[k] = __builtin_bit_cast(float, t1[4 + k]); p1[k] = t1[8 + k]; }
        const u32x2* x0 = (const u32x2*)(X1 + (size_t)m0 * DM) + lane; const u32x2* x1 = (const u32x2*)(X1 + (size_t)mb * DM) + lane;
        f32x4* q0 = (f32x4*)(OUT + (size_t)m0 * DM) + lane; f32x4* q1 = (f32x4*)(OUT + (size_t)mb * DM) + lane;
        f32x4 v0[4], v1[4]; unsigned y0[4][4], y1[4][4];
#pragma unroll
        for (int j = 0; j < 4; ++j) { { const u32x2 w0 = __builtin_nontemporal_load(x0 + 64 * j), w1 = __builtin_nontemporal_load(x1 + 64 * j); v0[j] = (f32x4){bflo(w0.x), bfhi(w0.x), bflo(w0.y), bfhi(w0.y)}; v1[j] = (f32x4){bflo(w1.x), bfhi(w1.x), bflo(w1.y), bfhi(w1.y)}; }
#pragma unroll
            for (int k = 0; k < 4; ++k) { y0[j][k] = __builtin_nontemporal_load((const unsigned*)(Y + (size_t)p0[k] * DM) + lane + 64 * j); y1[j][k] = __builtin_nontemporal_load((const unsigned*)(Y + (size_t)p1[k] * DM) + lane + 64 * j); } }
        float s0 = 0.f, s1 = 0.f;
#pragma unroll
        for (int j = 0; j < 4; ++j) {
#pragma unroll
            for (int k = 0; k < 4; ++k) {
                { const f32x2 lo = __builtin_amdgcn_cvt_pk_f32_fp8((int)y0[j][k], false), hi = __builtin_amdgcn_cvt_pk_f32_fp8((int)y0[j][k], true);
                  v0[j].x += g0[k] * lo.x; v0[j].y += g0[k] * lo.y; v0[j].z += g0[k] * hi.x; v0[j].w += g0[k] * hi.y; }
                { const f32x2 lo = __builtin_amdgcn_cvt_pk_f32_fp8((int)y1[j][k], false), hi = __builtin_amdgcn_cvt_pk_f32_fp8((int)y1[j][k], true);
                  v1[j].x += g1[k] * lo.x; v1[j].y += g1[k] * lo.y; v1[j].z += g1[k] * hi.x; v1[j].w += g1[k] * hi.y; } }
            s0 += (v0[j].x * v0[j].x + v0[j].y * v0[j].y) + (v0[j].z * v0[j].z + v0[j].w * v0[j].w);
            s1 += (v1[j].x * v1[j].x + v1[j].y * v1[j].y) + (v1[j].z * v1[j].z + v1[j].w * v1[j].w); }
        const float r0 = 1.0f / sqrtf(wave_sum(s0) * (1.0f / DM) + RMS_EPS), r1 = 1.0f / sqrtf(wave_sum(s1) * (1.0f / DM) + RMS_EPS);
#pragma unroll
        for (int j = 0; j < 4; ++j) { __builtin_nontemporal_store(v0[j] * r0 * gf[j], q0 + 64 * j); if (two) __builtin_nontemporal_store(v1[j] * r1 * gf[j], q1 + 64 * j); }
    }
}

#define XB_TMO      128
#define XB_XCNT(j)  (256  + 64 * (j))
#define XB_XSUB(j)  (1280 + 64 * (j))
#define XB_XGEN(j)  (2304 + 64 * (j))
#define XB_TOP      3328
#define XB_TOPGEN   3392
#define XCD_BAR_WORDS 3456
#define XB_SPIN_CAP (1u << 18)

__device__ __forceinline__ unsigned xb_ld(unsigned* p)              { return __hip_atomic_load(p, __ATOMIC_RELAXED, __HIP_MEMORY_SCOPE_AGENT); }
__device__ __forceinline__ unsigned xb_add(unsigned* p, unsigned v) { return __hip_atomic_fetch_add(p, v, __ATOMIC_RELAXED, __HIP_MEMORY_SCOPE_AGENT); }
__device__ __forceinline__ unsigned xb_xcc_id() { return (unsigned)__builtin_amdgcn_s_getreg((3 << 11) | 20) & 0xFu; }
#define XB_SPIN(cond, bar) do { unsigned _sp = 0; while (cond) { __builtin_amdgcn_s_sleep(1); \
    if ((++_sp & 255u) == 0u) { if (xb_ld(&(bar)[XB_TMO])) break; if (_sp > XB_SPIN_CAP) { atomicAdd(&(bar)[XB_TMO], 1u); break; } } } } while (0)

struct XcdBarrier {
    unsigned* bar; unsigned x;
    volatile LAS unsigned* st;
};

__device__ __forceinline__ XcdBarrier xcd_barrier_post(unsigned* bar, volatile LAS unsigned* st) {
    XcdBarrier b; b.bar = bar; b.x = xb_xcc_id(); b.st = st;
    if (threadIdx.x == 0) (void)xb_add(&bar[XB_XCNT(b.x)], 1u);
    return b;
}
__device__ __forceinline__ void xcd_barrier_complete(unsigned* bar, unsigned x, unsigned& nloc, unsigned& nx) {
    const unsigned G = gridDim.x * gridDim.y * gridDim.z;
    unsigned sum, cnt, mine, sp = 0u;
    for (;;) {
        sum = 0u; cnt = 0u; mine = 0u;
#pragma unroll
        for (unsigned j = 0; j < 16; ++j) { const unsigned c = xb_ld(&bar[XB_XCNT(j)]); sum += c; cnt += (c > 0u) ? 1u : 0u; mine = (j == x) ? c : mine; }
        if (sum == G) break;
        __builtin_amdgcn_s_sleep(1);
        if ((++sp & 255u) == 0u) { if (xb_ld(&bar[XB_TMO])) break; if (sp > XB_SPIN_CAP) { atomicAdd(&bar[XB_TMO], 1u); break; } }
    }
    nloc = mine > 0u ? mine : 1u; nx = cnt > 0u ? cnt : 1u;
}

__device__ __forceinline__ void xcd_barrier(const XcdBarrier& b) {
    asm volatile("s_waitcnt vmcnt(0)" ::: "memory");
    __syncthreads();
    if (threadIdx.x == 0) {
        unsigned* bar = b.bar;
        __builtin_amdgcn_s_waitcnt(0);
        unsigned nloc = b.st[0], nx = b.st[1];
        if (nloc == 0u) { xcd_barrier_complete(bar, b.x, nloc, nx); b.st[0] = nloc; b.st[1] = nx; }
        const unsigned old = xb_add(&bar[XB_XSUB(b.x)], 1u);
        const unsigned gen = old / nloc;
        if (old + 1u == (gen + 1u) * nloc) {
            __builtin_amdgcn_fence(__ATOMIC_RELEASE, "agent");
            asm volatile("s_waitcnt vmcnt(0)" ::: "memory");
            const unsigned og = xb_add(&bar[XB_TOP], 1u);
            const unsigned tg = og / nx;
            if (og + 1u == (tg + 1u) * nx) xb_add(&bar[XB_TOPGEN], 1u);
            else XB_SPIN(xb_ld(&bar[XB_TOPGEN]) == tg, bar);
            __builtin_amdgcn_fence(__ATOMIC_ACQUIRE, "agent");
            xb_add(&bar[XB_XGEN(b.x)], 1u);
            asm volatile("s_waitcnt vmcnt(0)" ::: "memory");
        } else {
            XB_SPIN(xb_ld(&bar[XB_XGEN(b.x)]) == gen, bar);
            __builtin_amdgcn_fence(__ATOMIC_ACQUIRE, "agent");
            asm volatile("s_waitcnt vmcnt(0)" ::: "memory");
        }
    }
    __syncthreads();
}


constexpr int NPHASE = 11;
__global__ void __launch_bounds__(NTHR, 2) fwd_kernel(Args a_) {
    extern __shared__ __attribute__((aligned(16))) unsigned char lds_raw[];
    cg::grid_group grid = cg::this_grid();
    Frame F; F.lds = (LAS unsigned char*)lds_raw; F.G = gridDim.x; F.bid = blockIdx.x;
    if (kargs()->ph_lo < 0) grid.sync();
    volatile LAS unsigned* bar_st = (volatile LAS unsigned*)(F.lds + LDS_BYTES - 16);
    if (threadIdx.x < 2) bar_st[threadIdx.x] = 0u;
    __syncthreads();
    const XcdBarrier xbar = xcd_barrier_post((unsigned*)(kargs()->ws + WS_CTL) + CW_BAR, bar_st);
#define REFRAME() do { int t_ = threadIdx.x; asm volatile("" : "+v"(t_)); F.tid = t_; F.lane = t_ & 63; F.wave = __builtin_amdgcn_readfirstlane(t_ >> 6); } while (0)
    REFRAME();
    const int lo = kargs()->ph_lo, hi = kargs()->ph_hi;
#define a (*kargs())
#define ws (kargs()->ws)
#ifndef PHMASK
#define PHMASK 0x7ff
#endif
#define IN(k) (((PHMASK >> (k)) & 1) && lo <= (k) && (k) < hi)
#define STAMP(k) do { if (TIMING_A >= 0 && blockIdx.x == 0 && threadIdx.x == 0) ((unsigned long long*)(ws + WS_CTL + 2048))[k] = __builtin_amdgcn_s_memrealtime(); } while (0)
#define REP(k) for (int rep_ = 0; rep_ < (((DOUBLE_MASK >> (k)) & 1) ? 2 : 1); ++rep_, (((DOUBLE_MASK >> (k)) & 1) && rep_ == 1 ? xcd_barrier(xbar) : (void)0))
#define SEAM(k) do { if (IN(k) && IN((k) + 1)) xcd_barrier(xbar); STAMP((k) + 1); } while (0)
    STAMP(0);
#ifndef P0_VAR
#define P0_VAR 7
#endif
    REFRAME(); REP(0) if (IN(0)) p0_prologue(F, a, rep_ == 0 ? 7 : P0_VAR);
    SEAM(0);
    REFRAME(); if (IN(1)) {
        pg8::Gemm g{ws + WS_XN, ws + WS_WIN, DM, 0};
        pg8::StaticOrder S; S.init(NTOK, PW, F.G, F.bid, ((DOUBLE_MASK >> 1) & 1) + 1);
        pg8::EpiProj E{(bf16_t*)(ws + WS_PROJ), (const float*)(ws + WS_ROPE)};
        pg8::gemm_phase<2, false>(F.lds, g, S, E);
    }
    SEAM(1);
    REFRAME(); REP(2) if (IN(2)) p2_ret_kv(F, a);
    SEAM(2);
    REFRAME(); REP(3) if (IN(3)) p3_ret_scan(F, a);
    SEAM(3);
    REFRAME(); if (IN(4)) p4_mixers(F, a);
    SEAM(4);
    REFRAME(); if (IN(5)) {
        pg8::Gemm g{ws + WS_MIX, ws + WS_WO, DM, 0};
        pg8::StaticOrder S; S.init(NTOK, DM, F.G, F.bid, ((DOUBLE_MASK >> 5) & 1) + 1);
        pg8::EpiRes E{a.x, (bf16_t*)(ws + WS_X1B)};
        pg8::gemm_phase<2, false>(F.lds, g, S, E);
    }
    SEAM(5);
    REFRAME(); REP(6) if (IN(6)) p6_router(F, a);
    SEAM(6);
    REFRAME(); REP(7) if (IN(7)) p7_scatter(F, a);
    SEAM(7);
    REFRAME(); if (IN(8)) {
        const int ntiles = build_tile_table(F, a);
        pg8::Gemm g{ws + WS_H2, ws + WS_WMI, DM, (size_t)2 * FF * DM};
        pg8::GroupedOrder S{ntiles, 8, ntiles * 8, F.G, F.bid, F.lds + LDS_MISC, ((DOUBLE_MASK >> 8) & 1) + 1};
        pg8::EpiSwiglu E{ws + WS_ACT, a.b_moe_in};
        build_row_table(F, a, S);
        pg8::gemm_phase<1, true>(F.lds, g, S, E);
    }
    SEAM(8);
    REFRAME(); if (IN(9)) {
        const int ntiles = build_tile_table(F, a);
        pg8::Gemm g{ws + WS_ACT, ws + WS_WMO, FF, (size_t)DM * FF};
        pg8::GroupedOrder S{ntiles, 4, ntiles * 4, F.G, F.bid, F.lds + LDS_MISC, ((DOUBLE_MASK >> 9) & 1) + 1};
        pg8::EpiY E{ws + WS_Y, a.b_moe_out};
        pg8::gemm_phase<1, false>(F.lds, g, S, E);
    }
    SEAM(9);
    REFRAME(); REP(10) if (IN(10)) p10_final(F, a);
    if (TIMING_A >= 0) {
        grid.sync(); STAMP(11); grid.sync();
        const unsigned long long* ts = (const unsigned long long*)(ws + WS_CTL + 2048);
        const float ta = (float)(ts[TIMING_A + 1] - ts[TIMING_A]) * 0.01f, tb = (float)(ts[TIMING_B + 1] - ts[TIMING_B]) * 0.01f;
        for (size_t i = (size_t)blockIdx.x * NTHR + threadIdx.x; i < (size_t)NTOK * DM; i += (size_t)gridDim.x * NTHR)
            a.out[i] = (i == 0) ? 4.0f * ta : ((i >= 1024 && i < 1024 + (1u << 22)) ? tb : 0.f);
    }
#undef IN
#undef SEAM
#undef a
#undef ws
}

#ifndef N_LAUNCHES
#define N_LAUNCHES 1
#endif
extern "C" void kernel_launch(void* const* d_in, const int* in_sizes, int n_in, void* d_out, int out_size, void* d_ws, size_t ws_size, hipStream_t stream) {
    static int grid = 0;
    if (grid == 0) {
        if (n_in != 19 || out_size != NTOK * DM || ws_size < WS_END) { fprintf(stderr, "kernel_launch: unexpected shapes (n_in %d out %d ws %zu)\n", n_in, out_size, ws_size); grid = -1; return; }
        int dev = 0, cus = 0, per_cu = 0;
        if (hipGetDevice(&dev) != hipSuccess || hipDeviceGetAttribute(&cus, hipDeviceAttributeMultiprocessorCount, dev) != hipSuccess) { grid = -1; return; }
        if (hipFuncSetAttribute((const void*)fwd_kernel, hipFuncAttributeMaxDynamicSharedMemorySize, LDS_BYTES) != hipSuccess) { fprintf(stderr, "kernel_launch: hipFuncSetAttribute failed\n"); grid = -1; return; }
        if (hipOccupancyMaxActiveBlocksPerMultiprocessor(&per_cu, (const void*)fwd_kernel, NTHR, LDS_BYTES) != hipSuccess || per_cu < 1) { fprintf(stderr, "kernel_launch: occupancy query says %d\n", per_cu); grid = -1; return; }
        grid = cus;
    }
    if (grid < 0) return;
    (void)hipMemsetAsync((char*)d_ws + WS_CTL, 0, CTL_ZERO_BYTES, stream);
    Args a{};
    a.x = (const float*)d_in[0]; a.positions = (const int*)d_in[1]; a.norm1_g = (const float*)d_in[2]; a.w_in = (const float*)d_in[3];
    a.lq1 = (const float*)d_in[4]; a.lk1 = (const float*)d_in[5]; a.lq2 = (const float*)d_in[6]; a.lk2 = (const float*)d_in[7];
    a.diff_g = (const float*)d_in[8]; a.ret_g = (const float*)d_in[9]; a.w_o = (const float*)d_in[10]; a.norm2_g = (const float*)d_in[11];
    a.w_router = (const float*)d_in[12]; a.b_router = (const float*)d_in[13]; a.w_moe_in = (const float*)d_in[14]; a.b_moe_in = (const float*)d_in[15];
    a.w_moe_out = (const float*)d_in[16]; a.b_moe_out = (const float*)d_in[17]; a.norm_f_g = (const float*)d_in[18];
    a.out = (float*)d_out; a.ws = (unsigned char*)d_ws;
    if (N_LAUNCHES == 1) {
        a.ph_lo = 0; a.ph_hi = NPHASE;
        void* args[] = {&a};
        hipError_t e = hipLaunchCooperativeKernel((const void*)fwd_kernel, dim3(grid), dim3(NTHR), args, LDS_BYTES, stream);
        if (e != hipSuccess) fprintf(stderr, "cooperative launch failed: %s\n", hipGetErrorString(e));
    } else {
        for (int p = 0; p < NPHASE; ++p) {
            a.ph_lo = p; a.ph_hi = p + 1;
            void* args[] = {&a};
            hipError_t e = hipLaunchCooperativeKernel((const void*)fwd_kernel, dim3(grid), dim3(NTHR), args, LDS_BYTES, stream);
            if (e != hipSuccess) { fprintf(stderr, "cooperative launch %d failed: %s\n", p, hipGetErrorString(e)); break; }
        }
    }
}
```
